# Optimizing an MI355X kernel written in HIP

```python
import math
import jax, jax.numpy as jnp
from jax import lax
import numpy as np

D_MODEL = 1024
BATCH = 32
SEQ = 2048
DEPTH = 2
DEC_BATCH = 16
DEC_SEQ = 64
PAST_LEN = 2048

CHUNK = 64
Q_BLOCK = 128
N_HEADS = 4
QK_HEAD_DIM = 64
V_HEAD_DIM = 2 * QK_HEAD_DIM
ATTN_WIDTH = N_HEADS * V_HEAD_DIM
CONV_WIDTH = D_MODEL - ATTN_WIDTH
MIX_WIDTH = ATTN_WIDTH + CONV_WIDTH
QK_WIDTH = N_HEADS * 2 * QK_HEAD_DIM
CONV_KERNEL = 31
CONV_STATE = CONV_KERNEL - 1
ROPE_THETA = 500000.0
ROT_DIM = QK_HEAD_DIM // 4
NORM_EPS = 1e-6
SUBLN_EPS = 1e-5
LN_EPS = 1e-5
_SPLITS = (QK_WIDTH, 2 * QK_WIDTH, 2 * QK_WIDTH + ATTN_WIDTH, 2 * QK_WIDTH + 2 * ATTN_WIDTH,
           2 * QK_WIDTH + 2 * ATTN_WIDTH + 2 * CONV_WIDTH)
IN_COLS = 2 * QK_WIDTH + 2 * ATTN_WIDTH + 3 * CONV_WIDTH

kernel_name = "hybrid_diffattn_conformer_stream_step"


def _rms_norm(x, g, eps):
    xf = x.astype(jnp.float32)
    y = xf * lax.rsqrt(jnp.mean(xf * xf, axis=-1, keepdims=True) + eps)
    return (y * g.astype(jnp.float32)).astype(x.dtype)


def _layer_norm(x, g, b, eps):
    xf = x.astype(jnp.float32)
    mu = jnp.mean(xf, axis=-1, keepdims=True)
    xc = xf - mu
    y = xc * lax.rsqrt(jnp.mean(xc * xc, axis=-1, keepdims=True) + eps)
    return (y * g.astype(jnp.float32) + b.astype(jnp.float32)).astype(x.dtype)


def _rope(x, posf):
    inv = jnp.float32(ROPE_THETA) ** (-jnp.arange(0, ROT_DIM, 2, dtype=jnp.float32) / ROT_DIM)
    ang = posf[:, None] * inv[None, :]
    cos = jnp.cos(ang)[None, :, None, None, :]
    sin = jnp.sin(ang)[None, :, None, None, :]
    xr = x[..., :ROT_DIM].astype(jnp.float32)
    x1, x2 = xr[..., : ROT_DIM // 2], xr[..., ROT_DIM // 2:]
    rot = jnp.concatenate([x1 * cos - x2 * sin, x2 * cos + x1 * sin], axis=-1)
    return jnp.concatenate([rot.astype(x.dtype), x[..., ROT_DIM:]], axis=-1)


def _diff_attn_block(q, k, v, qpos, kpos, lam):
    s = jnp.einsum('bqhmd,bkhmd->bhmqk', q.astype(jnp.float32), k.astype(jnp.float32)) * (QK_HEAD_DIM ** -0.5)
    allowed = (kpos[None, :] // CHUNK) <= (qpos[:, None] // CHUNK)
    s = jnp.where(allowed, s, -jnp.inf)
    p = jax.nn.softmax(s, axis=-1)
    a = p[:, :, 0] - lam * p[:, :, 1]
    return jnp.einsum('bhqk,bkhd->bqhd', a, v.astype(jnp.float32))


def _layer(x, c, pos, k_past, v_past, conv_past, layer_idx,
           w_ada, b_ada, g_pre, g_post, w_in, w_out,
           lam_q1, lam_k1, lam_q2, lam_k2, g_subln, w_dw, b_dw, g_ln, b_ln):
    B, S, _ = x.shape
    mod = jax.nn.silu(c) @ w_ada + b_ada
    shift, scale, gate = jnp.split(mod, 3, axis=-1)
    h = _rms_norm(x, g_pre, NORM_EPS) * (1 + scale[:, None, :]) + shift[:, None, :]
    z = h @ w_in
    q, k, v, ga, glu, gc = jnp.split(z, _SPLITS, axis=-1)
    q = q.reshape(B, S, N_HEADS, 2, QK_HEAD_DIM)
    k = k.reshape(B, S, N_HEADS, 2, QK_HEAD_DIM)
    v = v.reshape(B, S, N_HEADS, V_HEAD_DIM)
    posf = pos.astype(jnp.float32)
    q = _rope(q, posf)
    k = _rope(k, posf)

    lam_init = 0.8 - 0.6 * math.exp(-0.3 * layer_idx)
    lam = (jnp.exp(jnp.sum(lam_q1.astype(jnp.float32) * lam_k1.astype(jnp.float32)))
           - jnp.exp(jnp.sum(lam_q2.astype(jnp.float32) * lam_k2.astype(jnp.float32))) + lam_init)

    if k_past is None:
        outs = []
        for s0 in range(0, S, Q_BLOCK):
            e = min(s0 + Q_BLOCK, S)
            outs.append(_diff_attn_block(q[:, s0:e], k[:, :e], v[:, :e], pos[s0:e], pos[:e], lam))
        o = jnp.concatenate(outs, axis=1)
    else:
        k_all = jnp.concatenate([k_past.astype(k.dtype), k], axis=1)
        v_all = jnp.concatenate([v_past.astype(v.dtype), v], axis=1)
        kpos = jnp.arange(k_all.shape[1], dtype=jnp.int32)
        o = _diff_attn_block(q, k_all, v_all, pos, kpos, lam)
    o = _rms_norm(o, g_subln, SUBLN_EPS) * (1.0 - lam_init)
    attn_out = o.astype(x.dtype).reshape(B, S, ATTN_WIDTH) * jax.nn.silu(ga)

    ga_lin, gb = jnp.split(glu, 2, axis=-1)
    u = ga_lin * jax.nn.sigmoid(gb)
    if conv_past is None:
        past = jnp.zeros((B, CONV_STATE, CONV_WIDTH), u.dtype)
    else:
        past = conv_past.astype(u.dtype)
    u_pad = jnp.concatenate([past, u], axis=1)
    conv = lax.conv_general_dilated(u_pad, w_dw[:, None, :].astype(u.dtype), (1,), 'VALID',
                                    dimension_numbers=('NWC', 'WIO', 'NWC'),
                                    feature_group_count=CONV_WIDTH) + b_dw
    conv_out = jax.nn.silu(_layer_norm(conv, g_ln, b_ln, LN_EPS)) * jax.nn.silu(gc)

    m = jnp.concatenate([attn_out, conv_out], axis=-1) @ w_out
    y = x + gate[:, None, :] * _rms_norm(m, g_post, NORM_EPS)
    return y, k, v, u_pad[:, -CONV_STATE:]


def setup_inputs(seed: int = 0) -> dict:
    key = jax.random.key(seed)
    ks = jax.random.split(key, 24)
    f32 = jnp.float32
    nrm = lambda k, shape, s: jax.random.normal(k, shape, f32) * s
    return {
        "x_prompt": nrm(ks[0], (BATCH, SEQ, D_MODEL), 1.0),
        "x_sample": nrm(ks[1], (DEC_BATCH, DEC_SEQ, D_MODEL), 1.0),
        "c_prompt": nrm(ks[2], (BATCH, D_MODEL), 1.0),
        "c_sample": nrm(ks[3], (DEC_BATCH, D_MODEL), 1.0),
        "cache_k": nrm(ks[4], (DEPTH, DEC_BATCH, PAST_LEN, N_HEADS, 2, QK_HEAD_DIM), 1.0),
        "cache_v": nrm(ks[5], (DEPTH, DEC_BATCH, PAST_LEN, N_HEADS, V_HEAD_DIM), 1.0),
        "state_conv": nrm(ks[6], (DEPTH, DEC_BATCH, CONV_STATE, CONV_WIDTH), 0.5),
        "w_ada": nrm(ks[7], (DEPTH, D_MODEL, 3 * D_MODEL), 0.5 * D_MODEL ** -0.5),
        "b_ada": nrm(ks[8], (DEPTH, 3 * D_MODEL), 0.01),
        "g_pre": 1.0 + nrm(ks[9], (DEPTH, D_MODEL), 0.01),
        "g_post": 1.0 + nrm(ks[10], (DEPTH, D_MODEL), 0.01),
        "w_in": nrm(ks[11], (DEPTH, D_MODEL, IN_COLS), D_MODEL ** -0.5),
        "w_out": nrm(ks[12], (DEPTH, MIX_WIDTH, D_MODEL), MIX_WIDTH ** -0.5),
        "lam_q1": nrm(ks[13], (DEPTH, QK_HEAD_DIM), 0.1),
        "lam_k1": nrm(ks[14], (DEPTH, QK_HEAD_DIM), 0.1),
        "lam_q2": nrm(ks[15], (DEPTH, QK_HEAD_DIM), 0.1),
        "lam_k2": nrm(ks[16], (DEPTH, QK_HEAD_DIM), 0.1),
        "g_subln": 1.0 + nrm(ks[17], (DEPTH, V_HEAD_DIM), 0.01),
        "w_dw": nrm(ks[18], (DEPTH, CONV_KERNEL, CONV_WIDTH), CONV_KERNEL ** -0.5),
        "b_dw": nrm(ks[19], (DEPTH, CONV_WIDTH), 0.01),
        "g_ln": 1.0 + nrm(ks[20], (DEPTH, CONV_WIDTH), 0.01),
        "b_ln": nrm(ks[21], (DEPTH, CONV_WIDTH), 0.01),
    }


def reference(x_prompt, x_sample, c_prompt, c_sample, cache_k, cache_v, state_conv,
              w_ada, b_ada, g_pre, g_post, w_in, w_out,
              lam_q1, lam_k1, lam_q2, lam_k2, g_subln, w_dw, b_dw, g_ln, b_ln):
    pos_p = jnp.arange(x_prompt.shape[1], dtype=jnp.int32)
    pos_s = PAST_LEN + jnp.arange(x_sample.shape[1], dtype=jnp.int32)
    yp, ys = x_prompt, x_sample
    kp, vp, cp, kq, vq, cq = [], [], [], [], [], []
    for l in range(DEPTH):
        w = (w_ada[l], b_ada[l], g_pre[l], g_post[l], w_in[l], w_out[l],
             lam_q1[l], lam_k1[l], lam_q2[l], lam_k2[l], g_subln[l], w_dw[l], b_dw[l], g_ln[l], b_ln[l])
        yp, k1, v1, s1 = _layer(yp, c_prompt, pos_p, None, None, None, l, *w)
        ys, k2, v2, s2 = _layer(ys, c_sample, pos_s, cache_k[l], cache_v[l], state_conv[l], l, *w)
        kp.append(k1); vp.append(v1); cp.append(s1)
        kq.append(k2); vq.append(v2); cq.append(s2)
    return (yp, ys, jnp.stack(kp), jnp.stack(vp), jnp.stack(cp),
            jnp.stack(kq), jnp.stack(vq), jnp.stack(cq))
```

```cpp
#include <hip/hip_runtime.h>
#include <hip/hip_cooperative_groups.h>
#include <cstdio>
#include <cmath>
namespace cg = cooperative_groups;

typedef unsigned short bf16_t;
typedef short bf16x8 __attribute__((ext_vector_type(8)));
typedef float f32x4 __attribute__((ext_vector_type(4)));
typedef float f32x2 __attribute__((ext_vector_type(2)));
typedef float f32x16 __attribute__((ext_vector_type(16)));
typedef unsigned u32x2 __attribute__((ext_vector_type(2)));
typedef unsigned u32x4 __attribute__((ext_vector_type(4)));
typedef __bf16 bf16x2_t __attribute__((ext_vector_type(2)));
#define LDS __attribute__((address_space(3)))
#define DI __device__ __forceinline__

constexpr int DM = 1024, SEQ = 2048, DSQ = 64;
constexpr int MP = 32 * 2048, MS = 16 * 64, MT = MP + MS;
constexpr int INC = 3584;
constexpr long OFF_YP = 0, OFF_YS = 67108864L, OFF_KP = 68157440L, OFF_VP = 135266304L, OFF_CP = 202375168L,
               OFF_KS = 203358208L, OFF_VS = 204406784L, OFF_CS = 205455360L;
constexpr int SHM_BYTES = 131072 + 64 + 8 * 2304, QOFF = 131072, EPI_OFF = 131072 + 64;
constexpr int N_ATT_S = 64, N_ATT_P = 2048, N_CONV = 1040, N_MIX = N_ATT_S + N_ATT_P + N_CONV;

struct Params {
  const float *x_p, *x_s, *c_p, *c_s, *cache_k, *cache_v, *state_conv, *w_ada, *b_ada, *g_pre, *g_post, *w_in, *w_out,
      *lq1, *lk1, *lq2, *lk2, *g_subln, *w_dw, *b_dw, *g_ln, *b_ln;
  float* out;
  bf16_t *WtIn, *WtOut, *H, *Z, *Mo, *Vt, *Kc, *X1, *WtGluS;
  float *mod, *lam;
  f32x2* rope;
  unsigned* ctr;
  unsigned* bar;
  double inv[8];
  float lam_init[2];
  int phase_lo, phase_hi;
};

struct Params;
typedef const __attribute__((address_space(4))) Params* KP;
DI KP launder_p(KP q) { asm volatile("" : "+s"(q)); return q; }
DI int launder(int v) { asm volatile("" : "+v"(v)); return v; }
DI unsigned pk2(float a, float b) { f32x2 v = {a, b}; return __builtin_bit_cast(unsigned, __builtin_convertvector(v, bf16x2_t)); }
DI float bflo(unsigned u) { return __uint_as_float(u << 16); }
DI float bfhi(unsigned u) { return __uint_as_float(u & 0xffff0000u); }
DI float bf1(bf16_t u) { return __uint_as_float(((unsigned)u) << 16); }
DI float sigmoidf_(float x) { return __builtin_amdgcn_rcpf(1.0f + __builtin_amdgcn_exp2f(-1.44269504089f * x)); }
DI float siluf_(float x) { return x * sigmoidf_(x); }
DI float xhalf_max(float v) {
  const auto r = __builtin_amdgcn_permlane32_swap(__float_as_uint(v), __float_as_uint(v), false, false);
  return fmaxf(__uint_as_float(r[0]), __uint_as_float(r[1]));
}
DI float xhalf_sum(float v) {
  const auto r = __builtin_amdgcn_permlane32_swap(__float_as_uint(v), __float_as_uint(v), false, false);
  return __uint_as_float(r[0]) + __uint_as_float(r[1]);
}
DI float wave_sum(float v) {
  v += __shfl_xor(v, 32); v += __shfl_xor(v, 16); v += __shfl_xor(v, 8); v += __shfl_xor(v, 4); v += __shfl_xor(v, 2); v += __shfl_xor(v, 1);
  return v;
}

DI void sincos_d(double x, double& s, double& c) {
  const double kd = rint(x * 0.63661977236758134308);
  double r = fma(-kd, 1.57079632673412561417e+00, x);
  r = fma(-kd, 6.07710050650619224932e-11, r);
  const double r2 = r * r;
  double ps = 1.0 / 6227020800.0;
  ps = fma(ps, r2, -1.0 / 39916800.0); ps = fma(ps, r2, 1.0 / 362880.0); ps = fma(ps, r2, -1.0 / 5040.0);
  ps = fma(ps, r2, 1.0 / 120.0); ps = fma(ps, r2, -1.0 / 6.0);
  const double sn = fma(r * r2, ps, r);
  double pc = -1.0 / 87178291200.0;
  pc = fma(pc, r2, 1.0 / 479001600.0); pc = fma(pc, r2, -1.0 / 3628800.0); pc = fma(pc, r2, 1.0 / 40320.0);
  pc = fma(pc, r2, -1.0 / 720.0); pc = fma(pc, r2, 1.0 / 24.0); pc = fma(pc, r2, -0.5);
  const double cs = fma(pc, r2, 1.0);
  const int q = ((int)kd) & 3;
  s = (q == 0) ? sn : (q == 1) ? cs : (q == 2) ? -sn : -cs;
  c = (q == 0) ? cs : (q == 1) ? -sn : (q == 2) ? -cs : sn;
}

DI void mod_item(KP p, int it, LDS char* shm) {
  const int tid = launder(threadIdx.x);
  const int l = it / 72, rem = it % 72, nchunk = rem / 3, bg = rem % 3;
  LDS float* sc = (LDS float*)shm;
  LDS float* red = (LDS float*)(shm + 65536);
  for (int e = tid; e < 16384; e += 512) {
    const int k = e & 1023, bb = e >> 10;
    const float cv = (bg < 2) ? p->c_p[(bg * 16 + bb) * 1024 + k] : p->c_s[bb * 1024 + k];
    sc[k * 16 + bb] = siluf_(cv);
  }
  __syncthreads();
  const int col = tid & 127, kq = tid >> 7, n = nchunk * 128 + col;
  float acc[16];
#pragma unroll
  for (int i = 0; i < 16; ++i) acc[i] = 0.f;
  const float* wp = p->w_ada + ((long)l * 1024 + kq * 256) * 3072 + n;
#pragma unroll 4
  for (int k = 0; k < 256; ++k) {
    const float w = wp[(long)k * 3072];
    const LDS f32x4* s4 = (const LDS f32x4*)(sc + (kq * 256 + k) * 16);
#pragma unroll
    for (int q = 0; q < 4; ++q) { const f32x4 s = s4[q]; acc[q * 4 + 0] += s[0] * w; acc[q * 4 + 1] += s[1] * w; acc[q * 4 + 2] += s[2] * w; acc[q * 4 + 3] += s[3] * w; }
  }
#pragma unroll
  for (int i = 0; i < 16; ++i) red[(kq * 16 + i) * 128 + col] = acc[i];
  __syncthreads();
  for (int e = tid; e < 2048; e += 512) {
    const int bb = e >> 7, cc = e & 127, nn = nchunk * 128 + cc;
    const float v = red[(0 * 16 + bb) * 128 + cc] + red[(1 * 16 + bb) * 128 + cc] + red[(2 * 16 + bb) * 128 + cc] + red[(3 * 16 + bb) * 128 + cc] + p->b_ada[l * 3072 + nn];
    p->mod[((long)(l * 48 + bg * 16 + bb)) * 3072 + nn] = v;
  }
}

DI void misc_item(KP p) {
  const int tid = launder(threadIdx.x);
  for (int e = tid; e < 2112 * 8; e += 512) {
    const int pos = e >> 3, i = e & 7;
    double s, c; sincos_d((double)pos * p->inv[i], s, c);
    f32x2 v = {(float)c, (float)s};
    p->rope[e] = v;
  }
  if (tid < 2) {
    const int l = tid;
    float s1 = 0.f, s2 = 0.f;
    for (int d = 0; d < 64; ++d) { s1 += p->lq1[l * 64 + d] * p->lk1[l * 64 + d]; s2 += p->lq2[l * 64 + d] * p->lk2[l * 64 + d]; }
    p->lam[l] = expf(s1) - expf(s2) + p->lam_init[l];
    p->ctr[l] = 0u; p->ctr[l + 2] = 0u;
  }
}

DI void transpose_item(KP p, int idx, LDS char* shm) {
  const int tid = launder(threadIdx.x);
  const float* src; bf16_t* dst; int ldn, kt, nt;
  int ncol = -1;
  if (idx < 1792) { const int l = idx / 896, r = idx % 896; kt = r / 56; nt = r % 56; src = p->w_in + (long)l * 1024 * 3584; ldn = 3584; dst = p->WtIn + (long)l * 3584 * 1024;
    const int n0 = nt * 64; if (n0 >= 2048 && n0 < 3072) { const int t = (n0 - 2048) >> 8, w = (n0 - 2048) & 255; ncol = (w < 128) ? 2048 + 128 * t + w : 2560 + 128 * t + (w - 128); } }
  else if (idx >= 2304) { idx -= 2304; const int l = idx / 256, r = idx % 256; kt = r / 16; nt = r % 16; src = p->w_in + (long)l * 1024 * 3584; ldn = 3584; dst = p->WtGluS + (long)l * 1024 * 1024; ncol = 2048 + nt * 64; }
  else { idx -= 1792; const int l = idx / 256, r = idx % 256; kt = r / 16; nt = r % 16; src = p->w_out + (long)l * 1024 * 1024; ldn = 1024; dst = p->WtOut + (long)l * 1024 * 1024; }
  LDS float* tile = (LDS float*)shm;
#pragma unroll
  for (int i = 0; i < 2; ++i) {
    const int kk = (tid >> 4) + 32 * i, n4 = (tid & 15) * 4;
    const f32x4 v = __builtin_nontemporal_load((const f32x4*)(src + (long)(kt * 64 + kk) * ldn + (ncol >= 0 ? ncol : nt * 64) + n4));
    tile[kk * 65 + n4 + 0] = v[0]; tile[kk * 65 + n4 + 1] = v[1]; tile[kk * 65 + n4 + 2] = v[2]; tile[kk * 65 + n4 + 3] = v[3];
  }
  __syncthreads();
  const int nn = tid >> 3, k8 = (tid & 7) * 8;
  u32x4 o;
  o[0] = pk2(tile[(k8 + 0) * 65 + nn], tile[(k8 + 1) * 65 + nn]);
  o[1] = pk2(tile[(k8 + 2) * 65 + nn], tile[(k8 + 3) * 65 + nn]);
  o[2] = pk2(tile[(k8 + 4) * 65 + nn], tile[(k8 + 5) * 65 + nn]);
  o[3] = pk2(tile[(k8 + 6) * 65 + nn], tile[(k8 + 7) * 65 + nn]);
  *(u32x4*)(dst + (long)(nt * 64 + nn) * 1024 + kt * 64 + k8) = o;
}

DI void phase0(KP p, LDS char* shm) {
  constexpr int N_MOD = 144, N_TR = 2304 + 512;
  for (int it = blockIdx.x; it < N_MOD + 1 + N_TR; it += gridDim.x) {
    p = launder_p(p);
    if (it < N_MOD) mod_item(p, it, shm);
    else if (it == N_MOD) misc_item(p);
    else transpose_item(p, it - N_MOD - 1, shm);
    __syncthreads();
  }
}

template <int MODE>
DI void phase_rows(KP p) {
  const int tidr = launder(threadIdx.x), lane = tidr & 63, wid = tidr >> 6;
  const int gw = blockIdx.x * 8 + wid, nw = gridDim.x * 8;
  constexpr int lpre = (MODE == 0) ? 0 : 1;
  constexpr int lpost = (MODE == 1) ? 0 : 1;
  constexpr int R = 4;
  for (int row0 = gw * R; row0 < MT; row0 += nw * R) {
    const bool smp = row0 >= MP;
    const int b48 = smp ? 32 + ((row0 - MP) >> 6) : (row0 >> 11);
    const float* xin = smp ? p->x_s + (long)(row0 - MP) * 1024 : p->x_p + (long)row0 * 1024;
    float* xo = p->out + (smp ? OFF_YS + (long)(row0 - MP) * 1024 : OFF_YP + (long)row0 * 1024);
    const float* xs = (MODE == 2) ? xo : xin;
    f32x4 x[R][4];
    u32x2 mu[R][4];
    if (MODE == 2) {
#pragma unroll
      for (int r = 0; r < R; ++r)
#pragma unroll
        for (int i = 0; i < 4; ++i) {
          const u32x2 u = __builtin_nontemporal_load((const u32x2*)(p->X1 + (long)(row0 + r) * 1024 + lane * 4 + 256 * i));
          x[r][i][0] = bflo(u[0]); x[r][i][1] = bfhi(u[0]); x[r][i][2] = bflo(u[1]); x[r][i][3] = bfhi(u[1]);
        }
    } else {
#pragma unroll
      for (int r = 0; r < R; ++r)
#pragma unroll
        for (int i = 0; i < 4; ++i) x[r][i] = __builtin_nontemporal_load((const f32x4*)(xs + r * 1024 + lane * 4 + 256 * i));
    }
    if (MODE >= 1) {
#pragma unroll
      for (int r = 0; r < R; ++r)
#pragma unroll
        for (int i = 0; i < 4; ++i) mu[r][i] = __builtin_nontemporal_load((const u32x2*)(p->Mo + (long)(row0 + r) * 1024 + lane * 4 + 256 * i));
      const float* md = p->mod + (long)(lpost * 48 + b48) * 3072 + 2048;
      f32x4 gg[4];
#pragma unroll
      for (int i = 0; i < 4; ++i) gg[i] = *(const f32x4*)(md + lane * 4 + 256 * i) * *(const f32x4*)(p->g_post + lpost * 1024 + lane * 4 + 256 * i);
#pragma unroll
      for (int r = 0; r < R; ++r) {
        f32x4 m[4]; float ss = 0.f;
#pragma unroll
        for (int i = 0; i < 4; ++i) {
          const u32x2 u = mu[r][i];
          m[i][0] = bflo(u[0]); m[i][1] = bfhi(u[0]); m[i][2] = bflo(u[1]); m[i][3] = bfhi(u[1]);
          ss += m[i][0] * m[i][0] + m[i][1] * m[i][1] + m[i][2] * m[i][2] + m[i][3] * m[i][3];
        }
        ss = wave_sum(ss);
        const float rstd = rsqrtf(ss * (1.0f / 1024.0f) + 1e-6f);
#pragma unroll
        for (int i = 0; i < 4; ++i) x[r][i] = x[r][i] + gg[i] * (m[i] * rstd);
      }
#pragma unroll
      for (int r = 0; r < R; ++r)
#pragma unroll
        for (int i = 0; i < 4; ++i) {
          if (MODE == 2) *(f32x4*)(xo + r * 1024 + lane * 4 + 256 * i) = x[r][i];
          else { u32x2 o; o[0] = pk2(x[r][i][0], x[r][i][1]); o[1] = pk2(x[r][i][2], x[r][i][3]); *(u32x2*)(p->X1 + (long)(row0 + r) * 1024 + lane * 4 + 256 * i) = o; }
        }
    }
    if (MODE <= 1) {
      const float* md = p->mod + (long)(lpre * 48 + b48) * 3072;
      f32x4 sh[4], sg[4];
#pragma unroll
      for (int i = 0; i < 4; ++i) {
        sh[i] = *(const f32x4*)(md + lane * 4 + 256 * i);
        sg[i] = (*(const f32x4*)(md + 1024 + lane * 4 + 256 * i) + 1.0f) * *(const f32x4*)(p->g_pre + lpre * 1024 + lane * 4 + 256 * i);
      }
#pragma unroll
      for (int r = 0; r < R; ++r) {
        float ss = 0.f;
#pragma unroll
        for (int i = 0; i < 4; ++i) ss += x[r][i][0] * x[r][i][0] + x[r][i][1] * x[r][i][1] + x[r][i][2] * x[r][i][2] + x[r][i][3] * x[r][i][3];
        ss = wave_sum(ss);
        const float rstd = rsqrtf(ss * (1.0f / 1024.0f) + 1e-6f);
#pragma unroll
        for (int i = 0; i < 4; ++i) {
          const f32x4 hv = (x[r][i] * rstd) * sg[i] + sh[i];
          u32x2 o; o[0] = pk2(hv[0], hv[1]); o[1] = pk2(hv[2], hv[3]);
          *(u32x2*)(p->H + (long)(row0 + r) * 1024 + lane * 4 + 256 * i) = o;
        }
      }
    }
  }
}

DI int lds_byte2(int r, int c) { const int st = (r >> 4) * 2 + (c >> 5), ob = (r & 15) * 64 + (c & 31) * 2; return st * 1024 + (ob ^ (((ob >> 9) & 1) << 5)); }
DI void stage_rc2(int b, int& R, int& C) { const int st = b >> 10, sb = b & 1023, swz = sb ^ (((sb >> 9) & 1) << 5); R = (st / 2) * 16 + swz / 64; C = (st % 2) * 32 + (swz % 64) / 2; }

template <int EPI, int MREP>
DI void gemm_tiles(KP p, int l, LDS char* shm) {
  constexpr int K = 1024, BK = 64, BM = 32 * MREP, TILE_A = BM * BK * 2, TILE_B = 256 * BK * 2, GLA = TILE_A / 8192, GLB = 4;
  constexpr int STAGE_B = 65536, N = (EPI != 1) ? INC : DM, nN = N / 256, WGM = 8;
  constexpr int row_lo = (MREP == 8) ? 0 : MP;
  constexpr int nM = (MREP == 8) ? MP / 256 : MS / 64, nwg = nM * nN;
  const bf16_t* A = p->H;
  const bf16_t* Bt = (EPI != 1) ? p->WtIn + (long)l * INC * 1024 : p->WtOut + (long)l * 1024 * 1024;
  const int tid = launder(threadIdx.x), wid = tid >> 6, lane = tid & 63, wr = wid >> 2, wc = wid & 3, fr = lane & 15, fq = lane >> 4;
  int sRa[GLA], sCa[GLA], sRb[GLB], sCb[GLB];
#pragma unroll
  for (int i = 0; i < GLA; ++i) stage_rc2(wid * 1024 + i * 8192 + lane * 16, sRa[i], sCa[i]);
#pragma unroll
  for (int i = 0; i < GLB; ++i) stage_rc2(wid * 1024 + i * 8192 + lane * 16, sRb[i], sCb[i]);
  auto tile_of = [&](int it, int& brow, int& bcol) -> bool {
    const long L = (long)it * gridDim.x + blockIdx.x;
    if (L >= nwg) return false;
    int wgid = (int)L;
    if (MREP == 8) {
      { const int q = nwg / 8, r = nwg % 8, xcd = wgid % 8, off = wgid / 8; wgid = (xcd < r ? xcd * (q + 1) : r * (q + 1) + (xcd - r) * q) + off; }
      const int nig = WGM * nN, gid = wgid / nig, fm = gid * WGM, gsz = (nM - fm) < WGM ? (nM - fm) : WGM;
      brow = row_lo + (fm + ((wgid % nig) % gsz)) * BM; bcol = ((wgid % nig) / gsz) * 256;
    } else {
      brow = row_lo + (wgid % nM) * BM; bcol = (wgid / nM) * 256;
    }
    return true;
  };
#define SA_(b) (shm + (b) * STAGE_B)
#define SB_(b) (shm + (b) * STAGE_B + 32768)
#define GLDS_STAGE_(buf, kt, Ab_, Bb_) do { _Pragma("unroll") for (int i = 0; i < GLA; ++i) \
      __builtin_amdgcn_global_load_lds((const unsigned*)((Ab_) + (long)sRa[i] * K + (kt) * BK + sCa[i]), (LDS unsigned*)(SA_(buf) + wid * 1024 + i * 8192), 16, 0, 0); \
    _Pragma("unroll") for (int i = 0; i < GLB; ++i) \
      __builtin_amdgcn_global_load_lds((const unsigned*)((Bb_) + (long)sRb[i] * K + (kt) * BK + sCb[i]), (LDS unsigned*)(SB_(buf) + wid * 1024 + i * 8192), 16, 0, 0); } while (0)
  int brow, bcol;
  bool have = tile_of(0, brow, bcol);
  if (have) {
    GLDS_STAGE_(0, 0, A + (long)brow * K, ((EPI != 1 && bcol >= 2048 && bcol < 3072 && MREP != 8) ? p->WtGluS + (long)l * 1024 * 1024 + (long)(bcol - 2048) * K : Bt + (long)bcol * K));
    asm volatile("s_waitcnt vmcnt(0)" ::: "memory");
    __syncthreads();
  }
  for (int it = 0; have; ++it) {
    int nbrow = 0, nbcol = 0;
    const bool have_next = tile_of(it + 1, nbrow, nbcol);
    const bf16_t* Ab = A + (long)brow * K;
    const bf16_t* Bb = (EPI != 1 && bcol >= 2048 && bcol < 3072 && MREP != 8) ? p->WtGluS + (long)l * 1024 * 1024 + (long)(bcol - 2048) * K : Bt + (long)bcol * K;
    const bf16_t* nAb = A + (long)nbrow * K;
    const bf16_t* nBb = (EPI != 1 && nbcol >= 2048 && nbcol < 3072 && MREP != 8) ? p->WtGluS + (long)l * 1024 * 1024 + (long)(nbcol - 2048) * K : Bt + (long)nbcol * K;
    f32x4 acc[MREP][4];
#pragma unroll
    for (int m = 0; m < MREP; ++m)
#pragma unroll
      for (int n = 0; n < 4; ++n) acc[m][n] = (f32x4){0.f, 0.f, 0.f, 0.f};
    constexpr int nt = K / BK;
    for (int t = 0; t < nt; ++t) {
      const int cur = t & 1;
      if (t + 1 < nt) GLDS_STAGE_(cur ^ 1, t + 1, Ab, Bb);
      else if (have_next) GLDS_STAGE_(0, 0, nAb, nBb);
#pragma unroll
      for (int ks = 0; ks < 2; ++ks) {
        bf16x8 At[MREP], Bf[4];
#pragma unroll
        for (int m = 0; m < MREP; ++m) At[m] = *(const LDS bf16x8*)(SA_(cur) + lds_byte2(wr * (BM / 2) + m * 16 + fr, ks * 32 + fq * 8));
#pragma unroll
        for (int n = 0; n < 4; ++n) Bf[n] = *(const LDS bf16x8*)(SB_(cur) + lds_byte2(wc * 64 + n * 16 + fr, ks * 32 + fq * 8));
#pragma unroll
        for (int m = 0; m < MREP; ++m)
#pragma unroll
          for (int n = 0; n < 4; ++n) acc[m][n] = __builtin_amdgcn_mfma_f32_16x16x32_bf16(Bf[n], At[m], acc[m][n], 0, 0, 0);
        __builtin_amdgcn_sched_barrier(0);
      }
      asm volatile("s_waitcnt vmcnt(0)" ::: "memory");
      __syncthreads();
    }
    if (EPI == 0) {
      const int kind = bcol >> 9;
      const bool smp = (MREP != 8);
      if (kind < 2) {
#pragma unroll
        for (int m = 0; m < MREP; ++m) {
          const int row = brow + wr * (BM / 2) + m * 16 + fr;
          const int pos = smp ? 2048 + ((row - MP) & 63) : (row & 2047);
          f32x4 v = acc[m][0];
          const f32x4 cs0 = *(const f32x4*)((const float*)p->rope + (pos * 8 + (fq & 1) * 4) * 2);
          const f32x4 cs1 = *(const f32x4*)((const float*)p->rope + (pos * 8 + (fq & 1) * 4) * 2 + 4);
          const float sg = (fq < 2) ? -1.0f : 1.0f;
          f32x4 pr;
          pr[0] = __shfl_xor(v[0], 32); pr[1] = __shfl_xor(v[1], 32); pr[2] = __shfl_xor(v[2], 32); pr[3] = __shfl_xor(v[3], 32);
          v[0] = v[0] * cs0[0] + sg * pr[0] * cs0[1];
          v[1] = v[1] * cs0[2] + sg * pr[1] * cs0[3];
          v[2] = v[2] * cs1[0] + sg * pr[2] * cs1[1];
          v[3] = v[3] * cs1[2] + sg * pr[3] * cs1[3];
          acc[m][0] = v;
        }
      }
#pragma unroll
      for (int m = 0; m < MREP; ++m) {
        const int row = brow + wr * (BM / 2) + m * 16 + fr;
#pragma unroll
        for (int n = 0; n < 4; ++n) {
          f32x4 v = acc[m][n];
          const int col = bcol + wc * 64 + n * 16 + fq * 4;
          u32x2 o; o[0] = pk2(v[0], v[1]); o[1] = pk2(v[2], v[3]);
          *(u32x2*)(p->Z + (long)row * INC + col) = o;
          if (kind == 1 || kind == 2) {
            float* dst = smp ? p->out + (kind == 1 ? OFF_KS : OFF_VS) + ((long)l * MS + (row - MP)) * 512 + (col - kind * 512)
                             : p->out + (kind == 1 ? OFF_KP : OFF_VP) + ((long)l * MP + row) * 512 + (col - kind * 512);
            *(f32x4*)dst = v;
          }
        }
      }
    } else if (EPI == 2) {
      float sacc = 0.f;
#pragma unroll
      for (int m = 0; m < MREP; ++m)
#pragma unroll
        for (int n = 0; n < 4; ++n) sacc += acc[m][n][0] + acc[m][n][1] + acc[m][n][2] + acc[m][n][3];
      if (sacc == 123456.789f) p->lam[8] = sacc;
    } else {
#pragma unroll
      for (int m = 0; m < MREP; ++m) {
        const int row = brow + wr * (BM / 2) + m * 16 + fr;
#pragma unroll
        for (int n = 0; n < 4; ++n) {
          const f32x4 v = acc[m][n];
          const int col = bcol + wc * 64 + n * 16 + fq * 4;
          u32x2 o; o[0] = pk2(v[0], v[1]); o[1] = pk2(v[2], v[3]);
          *(u32x2*)(p->Mo + (long)row * DM + col) = o;
        }
      }
    }
    have = have_next; brow = nbrow; bcol = nbcol;
  }
  __syncthreads();
}


namespace pg8 {
#define PG8_LAS __attribute__((address_space(3)))
typedef unsigned short bf16_t;
typedef short bf16x8 __attribute__((ext_vector_type(8)));
typedef float f32x4 __attribute__((ext_vector_type(4)));
constexpr int BM = 256, BK = 64, HALF = 128, HTB = HALF * BK * 2, STAGE_BYTES = 8 * HTB, NXCD = 8, WGM = 8;
__device__ __forceinline__ int lds_byte(int r, int c) { const int st = (r >> 4) * 2 + (c >> 5), rr = r & 15, cc = c & 31, ob = rr * 64 + cc * 2; return st * 1024 + (ob ^ (((ob >> 9) & 1) << 5)); }
__device__ __forceinline__ void stage_rc(int b, int& R, int& C) { const int st = b / 1024, sb = b % 1024, swz = sb ^ (((sb >> 9) & 1) << 5); R = (st >> 1) * 16 + swz / 64; C = (st & 1) * 32 + (swz % 64) / 2; }
__device__ __forceinline__ int perm32(int rho) { const int n = rho >> 4, i = rho & 15; return 8 * (i >> 2) + 4 * n + (i & 3); }
struct Unit { int pm, pn; };
struct Gemm { const bf16_t* A; const bf16_t* Bt; int M, N, K; };
struct StaticOrder {
    int nM, nN, nwg, G, c;
    __device__ void init(int M, int N, int G_, int c_) { nM = M / BM; nN = N / BM; nwg = nM * nN; G = G_; c = c_; }
    __device__ bool next(int i, Unit& u) const {
        const long L = (long)i * G + c; if (L >= nwg) return false;
        int wgid = (int)L; { const int q = nwg / NXCD, r = nwg % NXCD, xcd = wgid % NXCD, off = wgid / NXCD; wgid = (xcd < r ? xcd * (q + 1) : r * (q + 1) + (xcd - r) * q) + off; }
        const int nig = WGM * nN, gid = wgid / nig, fm = gid * WGM, gsz = (nM - fm) < WGM ? (nM - fm) : WGM;
        u.pm = fm + ((wgid % nig) % gsz); u.pn = (wgid % nig) / gsz; return true;
    }
    __device__ __forceinline__ void a_ready(const Unit&) const {}
    __device__ __forceinline__ void done(const Unit&) const {}
};
template <class Epi, class Sched, bool ALIGN_EPI = false, bool SP2 = false>
__device__ __forceinline__ void gemm_phase(PG8_LAS unsigned char* lds, const Gemm g, const Sched& S, const Epi& E) {
    const int tid = launder(threadIdx.x), wid = __builtin_amdgcn_readfirstlane(tid >> 6), lane = tid & 63, wr = wid >> 2, wc = wid & 3, fr = lane & 15, fq = lane >> 4;
    const int K = g.K, nt = K / BK;
    unsigned voffA[2], voffB[2];
#pragma unroll
    for (int i = 0; i < 2; ++i) { int R, C; stage_rc(tid * 16 + i * 8192, R, C); const int Rb = Epi::PERM ? ((R & ~31) + perm32(R & 31)) : R;
        voffA[i] = (unsigned)(R * K + C) * 2u; voffB[i] = (unsigned)(Rb * K + C) * 2u; }
    const size_t kstep = (size_t)(BK * 2);
    const size_t hstep = (size_t)HALF * K * 2;
    const size_t tstep = 2 * hstep;
    const unsigned ldsw = (unsigned)wid * 1024u;
    const int aoff = lds_byte(wr * 64 + fr, fq * 8), boff = lds_byte(wc * 32 + fr, fq * 8);
#define PG8_SA(b, h) (((b) * 2 + (h)) * HTB)
#define PG8_SB(b, h) ((4 + (b) * 2 + (h)) * HTB)
#define PG8_STAGE(bufoff, gbase, voff) do { _Pragma("unroll") for (int _i = 0; _i < 2; ++_i) \
        __builtin_amdgcn_global_load_lds((const unsigned*)((const char*)(gbase) + (voff)[_i]), (PG8_LAS unsigned*)(lds + (bufoff) + ldsw + _i * 8192), 16, 0, 0); } while (0)
#define PG8_LDA(dst, b, h) do { _Pragma("unroll") for (int m = 0; m < 4; ++m) _Pragma("unroll") for (int k = 0; k < 2; ++k) dst[m][k] = *(const PG8_LAS bf16x8*)(lds + PG8_SA(b, h) + aoff + m * 2048 + k * 1024); } while (0)
#define PG8_LDB(dst, b, h) do { _Pragma("unroll") for (int n = 0; n < 2; ++n) _Pragma("unroll") for (int k = 0; k < 2; ++k) dst[n][k] = *(const PG8_LAS bf16x8*)(lds + PG8_SB(b, h) + boff + n * 2048 + k * 1024); } while (0)
#define PG8_MMA(ai, bj, At, Bt) do { __builtin_amdgcn_s_setprio(1); _Pragma("unroll") for (int m = 0; m < 4; ++m) _Pragma("unroll") for (int n = 0; n < 2; ++n) _Pragma("unroll") for (int k = 0; k < 2; ++k) \
        acc[ai][bj][m][n] = __builtin_amdgcn_mfma_f32_16x16x32_bf16(Bt[n][k], At[m][k], acc[ai][bj][m][n], 0, 0, 0); __builtin_amdgcn_s_setprio(0); } while (0)
#define PG8_WAIT_V(n) asm volatile("s_waitcnt vmcnt(" #n ")" ::: "memory")
#define PG8_WAIT_L(n) asm volatile("s_waitcnt lgkmcnt(" #n ")" ::: "memory")
#define PG8_BAR __builtin_amdgcn_s_barrier()
#define PG8_SCHED __builtin_amdgcn_sched_barrier(0)
    Unit cur, nxt; int ui = 0;
    if (!S.next(0, cur)) return;
    f32x4 acc[2][2][4][2];
#pragma unroll
    for (int a = 0; a < 2; ++a)
#pragma unroll
        for (int b = 0; b < 2; ++b)
#pragma unroll
            for (int m = 0; m < 4; ++m)
#pragma unroll
                for (int n = 0; n < 2; ++n) acc[a][b][m][n] = (f32x4){0.f, 0.f, 0.f, 0.f};
    bf16x8 At[4][2], B0[2][2], B1[2][2];
    const char* cA = (const char*)g.A + (size_t)cur.pm * tstep; const char* cB = (const char*)g.Bt + (size_t)cur.pn * tstep;
    S.a_ready(cur);
    if constexpr (SP2) {
        PG8_STAGE(PG8_SB(0, 0), cB, voffB); PG8_STAGE(PG8_SB(0, 1), cB + hstep, voffB); PG8_STAGE(PG8_SA(0, 0), cA, voffA); PG8_STAGE(PG8_SA(0, 1), cA + hstep, voffA);
        if (wr == 1) PG8_BAR;
        PG8_WAIT_V(2); PG8_BAR;
        PG8_STAGE(PG8_SB(1, 0), cB + kstep, voffB); PG8_STAGE(PG8_SA(1, 0), cA + kstep, voffA); PG8_STAGE(PG8_SB(1, 1), cB + hstep + kstep, voffB);
        PG8_WAIT_V(6); PG8_BAR;
    } else {
        PG8_STAGE(PG8_SB(0, 0), cB, voffB); PG8_STAGE(PG8_SA(0, 0), cA, voffA); PG8_STAGE(PG8_SB(0, 1), cB + hstep, voffB); PG8_STAGE(PG8_SA(0, 1), cA + hstep, voffA);
        if (wr == 1) PG8_BAR;
        PG8_WAIT_V(4); PG8_BAR;
        PG8_STAGE(PG8_SB(1, 0), cB + kstep, voffB); PG8_STAGE(PG8_SA(1, 0), cA + kstep, voffA); PG8_STAGE(PG8_SB(1, 1), cB + hstep + kstep, voffB);
        PG8_WAIT_V(6); PG8_BAR;
    }
    for (;;) {
        const bool has_next = S.next(ui + 1, nxt);
        const char* nA = has_next ? (const char*)g.A + (size_t)nxt.pm * tstep : cA; const char* nB = has_next ? (const char*)g.Bt + (size_t)nxt.pn * tstep : cB;
        for (int t = 0; t < nt; t += 2) {
            const bool last = (t == nt - 2);
            const char* a1 = cA + (size_t)(t + 1) * kstep;
            const char* a2 = last ? nA : cA + (size_t)(t + 2) * kstep; const char* b2 = last ? nB : cB + (size_t)(t + 2) * kstep;
            const char* a3 = a2 + kstep; const char* b3 = b2 + kstep;
            if (last && has_next) S.a_ready(nxt);
            if constexpr (SP2) {
            PG8_LDB(B0, 0, 0); PG8_LDB(B1, 0, 1); PG8_SCHED; PG8_LDA(At, 0, 0); PG8_STAGE(PG8_SA(1, 1), a1 + hstep, voffA);
            PG8_WAIT_V(8); PG8_WAIT_L(0); PG8_BAR; PG8_MMA(0, 0, At, B0); PG8_MMA(0, 1, At, B1); PG8_BAR; PG8_SCHED;
            PG8_LDA(At, 0, 1); PG8_STAGE(PG8_SB(0, 0), b2, voffB); PG8_STAGE(PG8_SB(0, 1), b2 + hstep, voffB); PG8_STAGE(PG8_SA(0, 0), a2, voffA);
            PG8_WAIT_V(8); PG8_WAIT_L(0); PG8_BAR; PG8_MMA(1, 0, At, B0); PG8_MMA(1, 1, At, B1); PG8_BAR; PG8_SCHED;
            PG8_LDB(B0, 1, 0); PG8_LDB(B1, 1, 1); PG8_SCHED; PG8_LDA(At, 1, 0); PG8_STAGE(PG8_SA(0, 1), a2 + hstep, voffA);
            PG8_WAIT_V(8); PG8_WAIT_L(0); PG8_BAR; PG8_MMA(0, 0, At, B0); PG8_MMA(0, 1, At, B1); PG8_BAR; PG8_SCHED;
            PG8_LDA(At, 1, 1); PG8_STAGE(PG8_SB(1, 0), b3, voffB); PG8_STAGE(PG8_SB(1, 1), b3 + hstep, voffB); PG8_STAGE(PG8_SA(1, 0), a3, voffA);
            PG8_WAIT_V(8); PG8_WAIT_L(0); PG8_BAR; PG8_MMA(1, 0, At, B0); PG8_MMA(1, 1, At, B1); PG8_BAR; PG8_SCHED;
            } else {
            PG8_LDB(B0, 0, 0); PG8_SCHED; PG8_LDA(At, 0, 0); PG8_STAGE(PG8_SA(1, 1), a1 + hstep, voffA);
            PG8_WAIT_L(8); PG8_BAR; PG8_WAIT_L(0); PG8_MMA(0, 0, At, B0); PG8_BAR; PG8_SCHED;
            PG8_LDB(B1, 0, 1); PG8_STAGE(PG8_SB(0, 0), b2, voffB);
            PG8_BAR; PG8_WAIT_L(0); PG8_MMA(0, 1, At, B1); PG8_BAR;
            PG8_LDA(At, 0, 1); PG8_STAGE(PG8_SA(0, 0), a2, voffA);
            PG8_BAR; PG8_WAIT_L(0); PG8_MMA(1, 0, At, B0); PG8_BAR; PG8_SCHED;
            PG8_STAGE(PG8_SB(0, 1), b2 + hstep, voffB);
            PG8_WAIT_V(6); PG8_BAR; PG8_MMA(1, 1, At, B1); PG8_BAR;
            PG8_LDB(B0, 1, 0); PG8_SCHED; PG8_LDA(At, 1, 0); PG8_STAGE(PG8_SA(0, 1), a2 + hstep, voffA);
            PG8_WAIT_L(8); PG8_BAR; PG8_WAIT_L(0); PG8_MMA(0, 0, At, B0); PG8_BAR; PG8_SCHED;
            PG8_LDB(B1, 1, 1); PG8_STAGE(PG8_SB(1, 0), b3, voffB);
            PG8_BAR; PG8_WAIT_L(0); PG8_MMA(0, 1, At, B1); PG8_BAR;
            PG8_LDA(At, 1, 1); PG8_STAGE(PG8_SA(1, 0), a3, voffA);
            PG8_BAR; PG8_WAIT_L(0); PG8_MMA(1, 0, At, B0); PG8_BAR; PG8_SCHED;
            PG8_STAGE(PG8_SB(1, 1), b3 + hstep, voffB);
            PG8_WAIT_V(6); PG8_BAR; PG8_MMA(1, 1, At, B1); PG8_BAR;
            }
        }
        if constexpr (ALIGN_EPI) { if (wr == 0) PG8_BAR; }
        if constexpr (!Epi::AFTER_DRAIN) { E(acc, cur, wr, wc, fr, fq); S.done(cur); }
        if (!has_next) break;
#pragma unroll
        for (int a = 0; a < 2; ++a)
#pragma unroll
            for (int b = 0; b < 2; ++b)
#pragma unroll
                for (int m = 0; m < 4; ++m)
#pragma unroll
                    for (int n = 0; n < 2; ++n) acc[a][b][m][n] = (f32x4){0.f, 0.f, 0.f, 0.f};
        cur = nxt; cA = nA; cB = nB; ++ui;
        if constexpr (ALIGN_EPI) { if (wr == 1) PG8_BAR; }
    }
    PG8_WAIT_V(0);
    if constexpr (!ALIGN_EPI) { if (wr == 0) PG8_BAR; }
    PG8_BAR;
    if constexpr (Epi::AFTER_DRAIN) { E.fused(acc, cur, wr, wc, fr, fq, lds, wid, lane); S.done(cur); }
#undef PG8_SA
#undef PG8_SB
#undef PG8_STAGE
#undef PG8_LDA
#undef PG8_LDB
#undef PG8_MMA
#undef PG8_WAIT_V
#undef PG8_WAIT_L
#undef PG8_BAR
#undef PG8_SCHED
}
}

struct EpiIn {
  static constexpr bool PERM = true, AFTER_DRAIN = false;
  KP p; int l; LDS char* stg;
  DI void operator()(f32x4 (&acc)[2][2][4][2], const pg8::Unit& u, int wr, int wc, int fr_, int fq_) const {
    const int ln = launder((int)__lane_id()), fr = ln & 15, fq = ln >> 4;
    const int kind = u.pn >> 1;
    if (kind < 2 && (wc & 1) == 0) {
      const float sg = (fq == 0) ? -1.0f : 1.0f;
#pragma unroll
      for (int ai = 0; ai < 2; ++ai)
#pragma unroll
        for (int m = 0; m < 4; ++m) {
          const int row = u.pm * 256 + ai * 128 + wr * 64 + m * 16 + fr;
          const float* tb = (const float*)p->rope + (row & 2047) * 16;
          const f32x4 t0 = *(const f32x4*)tb, t1 = *(const f32x4*)(tb + 4), t2 = *(const f32x4*)(tb + 8), t3 = *(const f32x4*)(tb + 12);
#pragma unroll
          for (int bj = 0; bj < 2; ++bj) {
            f32x4 v0 = acc[ai][bj][m][0], v1 = acc[ai][bj][m][1], q0, q1;
#pragma unroll
            for (int j = 0; j < 4; ++j) { q0[j] = __shfl_xor(v0[j], 16); q1[j] = __shfl_xor(v1[j], 16); }
            f32x4 n0, n1;
            n0[0] = v0[0] * t0[0] + sg * q0[0] * t0[1]; n0[1] = v0[1] * t0[2] + sg * q0[1] * t0[3];
            n0[2] = v0[2] * t1[0] + sg * q0[2] * t1[1]; n0[3] = v0[3] * t1[2] + sg * q0[3] * t1[3];
            n1[0] = v1[0] * t2[0] + sg * q1[0] * t2[1]; n1[1] = v1[1] * t2[2] + sg * q1[1] * t2[3];
            n1[2] = v1[2] * t3[0] + sg * q1[2] * t3[1]; n1[3] = v1[3] * t3[2] + sg * q1[3] * t3[3];
            if (fq < 2) { acc[ai][bj][m][0] = n0; acc[ai][bj][m][1] = n1; }
          }
        }
    }
#pragma unroll
    for (int ai = 0; ai < 2; ++ai)
#pragma unroll
      for (int m = 0; m < 4; ++m) {
        const int row = u.pm * 256 + ai * 128 + wr * 64 + m * 16 + fr;
#pragma unroll
        for (int bj = 0; bj < 2; ++bj) {
          const f32x4 v0 = acc[ai][bj][m][0], v1 = acc[ai][bj][m][1];
          const int col = u.pn * 256 + bj * 128 + wc * 32 + 8 * fq;
          if (u.pn >= 8 && u.pn < 12) {
            if (bj == 0) {
              const f32x4 g0 = acc[ai][1][m][0], g1 = acc[ai][1][m][1];
              f32x4 u0, u1;
#pragma unroll
              for (int j = 0; j < 4; ++j) { u0[j] = v0[j] * sigmoidf_(g0[j]); u1[j] = v1[j] * sigmoidf_(g1[j]); }
              const int ch = 128 * (u.pn - 8) + wc * 32 + 8 * fq;
              u32x4 ou; ou[0] = pk2(u0[0], u0[1]); ou[1] = pk2(u0[2], u0[3]); ou[2] = pk2(u1[0], u1[1]); ou[3] = pk2(u1[2], u1[3]);
              *(u32x4*)(p->Z + (long)row * INC + 2048 + ch) = ou;
              const int sq = row & 2047;
              if (sq >= 2018) { float* d = p->out + OFF_CP + ((long)(l * 32 + (row >> 11)) * 30 + (sq - 2018)) * 512 + ch; *(f32x4*)d = u0; *(f32x4*)(d + 4) = u1; }
            }
            continue;
          }
          u32x4 o; o[0] = pk2(v0[0], v0[1]); o[1] = pk2(v0[2], v0[3]); o[2] = pk2(v1[0], v1[1]); o[3] = pk2(v1[2], v1[3]);
          if (kind == 1) {
            const int ck = col - 512;
            *(u32x4*)(p->Kc + ((long)((row >> 11) * 8 + (ck >> 6)) * 2048 + (row & 2047)) * 64 + (ck & 63)) = o;
          } else if (kind != 2) *(u32x4*)(p->Z + (long)row * INC + col) = o;
          else {
            LDS bf16_t* sb = (LDS bf16_t*)(stg + (wr * 4 + wc) * 2304);
#pragma unroll
            for (int j = 0; j < 4; ++j) {
              sb[(8 * fq + 2 * j) * 16 + fr] = (bf16_t)(o[j] & 0xffffu);
              sb[(8 * fq + 2 * j + 1) * 16 + fr] = (bf16_t)(o[j] >> 16);
            }
            const u32x4 tv = *(const LDS u32x4*)(sb + (ln >> 1) * 16 + (ln & 1) * 8);
            const int tok0 = u.pm * 256 + ai * 128 + wr * 64 + m * 16;
            const int cv = (u.pn - 4) * 256 + bj * 128 + wc * 32 + (ln >> 1);
            *(u32x4*)(p->Vt + (((long)((tok0 >> 11) * 4 + (cv >> 7)) * 32 + ((tok0 & 2047) >> 6)) * 128 + (cv & 127)) * 64 + (tok0 & 63) + (ln & 1) * 8) = tv;
          }
          if (kind == 1 || kind == 2) {
            LDS float* st = (LDS float*)(stg + (wr * 4 + wc) * 2304);
            *(LDS f32x4*)(st + fr * 36 + 8 * fq) = v0; *(LDS f32x4*)(st + fr * 36 + 8 * fq + 4) = v1;
            const int rbase = u.pm * 256 + ai * 128 + wr * 64 + m * 16;
            float* dst = p->out + (kind == 1 ? OFF_KP : OFF_VP) + ((long)l * MP + rbase) * 512 + (u.pn * 256 + bj * 128 + wc * 32 - kind * 512);
            const f32x4 w0 = *(const LDS f32x4*)(st + (ln >> 3) * 36 + (ln & 7) * 4);
            const f32x4 w1 = *(const LDS f32x4*)(st + (8 + (ln >> 3)) * 36 + (ln & 7) * 4);
            __builtin_nontemporal_store(w0, (f32x4*)(dst + (long)(ln >> 3) * 512 + (ln & 7) * 4));
            __builtin_nontemporal_store(w1, (f32x4*)(dst + (long)(8 + (ln >> 3)) * 512 + (ln & 7) * 4));
          }
        }
      }
  }
};
struct EpiOut {
  static constexpr bool PERM = true, AFTER_DRAIN = false;
  KP p;
  DI void operator()(f32x4 (&acc)[2][2][4][2], const pg8::Unit& u, int wr, int wc, int fr_, int fq_) const {
    const int ln = launder((int)__lane_id()), fr = ln & 15, fq = ln >> 4;
#pragma unroll
    for (int ai = 0; ai < 2; ++ai)
#pragma unroll
      for (int m = 0; m < 4; ++m) {
        const int row = u.pm * 256 + ai * 128 + wr * 64 + m * 16 + fr;
#pragma unroll
        for (int bj = 0; bj < 2; ++bj) {
          const f32x4 v0 = acc[ai][bj][m][0], v1 = acc[ai][bj][m][1];
          const int col = u.pn * 256 + bj * 128 + wc * 32 + 8 * fq;
          u32x4 o; o[0] = pk2(v0[0], v0[1]); o[1] = pk2(v0[2], v0[3]); o[2] = pk2(v1[0], v1[1]); o[3] = pk2(v1[2], v1[3]);
          *(u32x4*)(p->Mo + (long)row * DM + col) = o;
        }
      }
  }
};

template <int EPI>
DI void gemm_phase(KP p, int l, LDS char* shm) {
  {
    KP q = launder_p(p);
    pg8::StaticOrder S; S.init(MP, (EPI != 1) ? INC : DM, (int)gridDim.x, (int)blockIdx.x);
    pg8::Gemm g; g.A = q->H; g.Bt = (EPI != 1) ? q->WtIn + (long)l * INC * 1024 : q->WtOut + (long)l * 1024 * 1024; g.M = MP; g.N = (EPI != 1) ? INC : DM; g.K = 1024;
    if (EPI != 1) { EpiIn E; E.p = q; E.l = l; E.stg = shm + EPI_OFF; pg8::gemm_phase<EpiIn, pg8::StaticOrder, true, true>((PG8_LAS unsigned char*)shm, g, S, E); }
    else { EpiOut E; E.p = q; pg8::gemm_phase<EpiOut, pg8::StaticOrder, true, true>((PG8_LAS unsigned char*)shm, g, S, E); }
    __syncthreads();
  }
  gemm_tiles<EPI, 2>(launder_p(p), l, shm);
}

constexpr int KROW = 144, STG = 2 * 64 * KROW + 128 * KROW;
DI int permk(int i) { return (i & 0x13) | ((i & 8) >> 1) | ((i & 4) << 1); }

template <bool SAMPLE>
DI void attn_unit(KP p, int l, int b, int h, int qb, LDS char* shm) {
  const int tid = launder(threadIdx.x), wid = tid >> 6, lane = tid & 63, rg = wid & 3, map = wid >> 2, r = lane & 31, hh = lane >> 5;
  const int rowbase = SAMPLE ? MP + b * 64 : b * 2048;
  const int nt = SAMPLE ? 33 : 2 * qb + 2;
  const int my_nt = SAMPLE ? (rg < 2 ? 33 : 0) : (2 * qb + 1 + (rg >> 1));
  const int qrow = rowbase + (SAMPLE ? (rg & 1) * 32 : qb * 128 + rg * 32) + r;
  bf16x8 qf[4];
#pragma unroll
  for (int t4 = 0; t4 < 4; ++t4) qf[t4] = *(const bf16x8*)(p->Z + (long)qrow * INC + h * 128 + map * 64 + 16 * t4 + 8 * hh);

  f32x4 kf32[2][2], vf32[4];
  u32x4 kb[2]; u32x2 vb[4];
  const int kkey0 = tid >> 4, kch = tid & 15;
  const int vkg = tid >> 5, vdg = tid & 31;
  auto issue = [&](int t) {
    if (SAMPLE && t < 32) {
      const float* ck = p->cache_k + (((long)(l * 16 + b) * 2048 + t * 64) * 512 + h * 128 + kch * 8);
#pragma unroll
      for (int i = 0; i < 2; ++i) { const float* s = ck + (long)(kkey0 + 32 * i) * 512; kf32[i][0] = *(const f32x4*)s; kf32[i][1] = *(const f32x4*)(s + 4); }
      const float* cv = p->cache_v + (((long)(l * 16 + b) * 2048 + t * 64 + 4 * vkg) * 512 + h * 128 + 4 * vdg);
#pragma unroll
      for (int kk = 0; kk < 4; ++kk) vf32[kk] = *(const f32x4*)(cv + (long)kk * 512);
    } else {
      const long r0 = rowbase + (SAMPLE ? 0 : t * 64);
#pragma unroll
      for (int i = 0; i < 2; ++i) kb[i] = *(const u32x4*)(p->Z + (r0 + kkey0 + 32 * i) * INC + 512 + h * 128 + kch * 8);
#pragma unroll
      for (int kk = 0; kk < 4; ++kk) vb[kk] = *(const u32x2*)(p->Z + (r0 + 4 * vkg + kk) * INC + 1024 + h * 128 + 4 * vdg);
    }
  };
  auto commit = [&](int t, int buf) {
    LDS char* ks = shm + buf * STG;
    LDS char* vs = ks + 2 * 64 * KROW;
    if (SAMPLE && t < 32) {
#pragma unroll
      for (int i = 0; i < 2; ++i) {
        u32x4 o; o[0] = pk2(kf32[i][0][0], kf32[i][0][1]); o[1] = pk2(kf32[i][0][2], kf32[i][0][3]); o[2] = pk2(kf32[i][1][0], kf32[i][1][1]); o[3] = pk2(kf32[i][1][2], kf32[i][1][3]);
        *(LDS u32x4*)(ks + ((kch >> 3) * 64 + kkey0 + 32 * i) * KROW + (kch & 7) * 16) = o;
      }
#pragma unroll
      for (int dd = 0; dd < 4; ++dd) {
        u32x2 o; o[0] = pk2(vf32[0][dd], vf32[1][dd]); o[1] = pk2(vf32[2][dd], vf32[3][dd]);
        *(LDS u32x2*)(vs + (4 * vdg + dd) * KROW + ((((vkg >> 1) ^ (vdg >> 1)) & 7) << 4) + 8 * (vkg & 1)) = o;
      }
    } else {
#pragma unroll
      for (int i = 0; i < 2; ++i) *(LDS u32x4*)(ks + ((kch >> 3) * 64 + kkey0 + 32 * i) * KROW + (kch & 7) * 16) = kb[i];
      u32x2 o;
      o[0] = (vb[0][0] & 0xffffu) | (vb[1][0] << 16); o[1] = (vb[2][0] & 0xffffu) | (vb[3][0] << 16);
      *(LDS u32x2*)(vs + (4 * vdg + 0) * KROW + ((((vkg >> 1) ^ (vdg >> 1)) & 7) << 4) + 8 * (vkg & 1)) = o;
      o[0] = (vb[0][0] >> 16) | (vb[1][0] & 0xffff0000u); o[1] = (vb[2][0] >> 16) | (vb[3][0] & 0xffff0000u);
      *(LDS u32x2*)(vs + (4 * vdg + 1) * KROW + ((((vkg >> 1) ^ (vdg >> 1)) & 7) << 4) + 8 * (vkg & 1)) = o;
      o[0] = (vb[0][1] & 0xffffu) | (vb[1][1] << 16); o[1] = (vb[2][1] & 0xffffu) | (vb[3][1] << 16);
      *(LDS u32x2*)(vs + (4 * vdg + 2) * KROW + ((((vkg >> 1) ^ (vdg >> 1)) & 7) << 4) + 8 * (vkg & 1)) = o;
      o[0] = (vb[0][1] >> 16) | (vb[1][1] & 0xffff0000u); o[1] = (vb[2][1] >> 16) | (vb[3][1] & 0xffff0000u);
      *(LDS u32x2*)(vs + (4 * vdg + 3) * KROW + ((((vkg >> 1) ^ (vdg >> 1)) & 7) << 4) + 8 * (vkg & 1)) = o;
    }
  };

  f32x16 O[4];
#pragma unroll
  for (int dt = 0; dt < 4; ++dt)
#pragma unroll
    for (int g = 0; g < 16; ++g) O[dt][g] = 0.f;
  float m_run = -1e30f, l_run = 0.f;
  const float cscale = 0.125f * 1.44269504089f;
  const int pr = permk(r);

  issue(0); commit(0, 0);
  __syncthreads();
  for (int t = 0; t < nt; ++t) {
    const int cur = t & 1;
    if (t + 1 < nt) issue(t + 1);
    if (t < my_nt) {
      const LDS char* ks = shm + cur * STG + map * (64 * KROW);
      const LDS char* vs = shm + cur * STG + 2 * 64 * KROW;
      f32x16 X0, X1;
#pragma unroll
      for (int g = 0; g < 16; ++g) { X0[g] = 0.f; X1[g] = 0.f; }
#pragma unroll
      for (int t4 = 0; t4 < 4; ++t4) {
        const bf16x8 k0 = *(const LDS bf16x8*)(ks + pr * KROW + (16 * t4 + 8 * hh) * 2);
        const bf16x8 k1 = *(const LDS bf16x8*)(ks + (32 + pr) * KROW + (16 * t4 + 8 * hh) * 2);
        X0 = __builtin_amdgcn_mfma_f32_32x32x16_bf16(k0, qf[t4], X0, 0, 0, 0);
        X1 = __builtin_amdgcn_mfma_f32_32x32x16_bf16(k1, qf[t4], X1, 0, 0, 0);
      }
      float mx = X0[0];
#pragma unroll
      for (int g = 1; g < 16; ++g) mx = fmaxf(mx, X0[g]);
#pragma unroll
      for (int g = 0; g < 16; ++g) mx = fmaxf(mx, X1[g]);
      mx = fmaxf(mx, __shfl_xor(mx, 32));
      const bool need = (mx - m_run) * cscale > 8.0f;
      float alpha = 1.0f;
      if (__any(need)) {
        const float mnew = fmaxf(m_run, mx);
        alpha = __builtin_amdgcn_exp2f((m_run - mnew) * cscale);
        m_run = mnew;
#pragma unroll
        for (int dt = 0; dt < 4; ++dt)
#pragma unroll
          for (int g = 0; g < 16; ++g) O[dt][g] *= alpha;
      }
      const float mc = m_run * cscale;
      float ls = 0.f;
#pragma unroll
      for (int g = 0; g < 16; ++g) { X0[g] = __builtin_amdgcn_exp2f(X0[g] * cscale - mc); ls += X0[g]; }
#pragma unroll
      for (int g = 0; g < 16; ++g) { X1[g] = __builtin_amdgcn_exp2f(X1[g] * cscale - mc); ls += X1[g]; }
      l_run = l_run * alpha + ls;
      bf16x8 pb[2][2];
#pragma unroll
      for (int s = 0; s < 2; ++s) {
        u32x4 a, c;
#pragma unroll
        for (int j = 0; j < 4; ++j) { a[j] = pk2(X0[8 * s + 2 * j], X0[8 * s + 2 * j + 1]); c[j] = pk2(X1[8 * s + 2 * j], X1[8 * s + 2 * j + 1]); }
        pb[0][s] = __builtin_bit_cast(bf16x8, a); pb[1][s] = __builtin_bit_cast(bf16x8, c);
      }
#pragma unroll
      for (int dt = 0; dt < 4; ++dt)
#pragma unroll
        for (int kh = 0; kh < 2; ++kh)
#pragma unroll
          for (int s = 0; s < 2; ++s) {
            const bf16x8 vf = *(const LDS bf16x8*)(vs + (dt * 32 + r) * KROW + ((((kh * 4 + s * 2 + hh) ^ ((dt & 1) * 4 + (r >> 3))) & 7) << 4));
            O[dt] = __builtin_amdgcn_mfma_f32_32x32x16_bf16(vf, pb[kh][s], O[dt], 0, 0, 0);
          }
    }
    if (t + 1 < nt) commit(t + 1, cur ^ 1);
    __syncthreads();
  }
  const bool active = !SAMPLE || rg < 2;
  u32x2 gav[16]; f32x4 gsv[16];
  if (map == 0) {
#pragma unroll
    for (int i = 0; i < 16; ++i) {
      const int dv0 = (i >> 2) * 32 + 8 * (i & 3) + 4 * hh;
      gsv[i] = *(const f32x4*)(p->g_subln + l * 128 + dv0);
      gav[i] = *(const u32x2*)(p->Z + (long)qrow * INC + 1536 + h * 128 + dv0);
    }
  }
  const float ltot = l_run + __shfl_xor(l_run, 32);
  const float inv_l = active ? 1.0f / ltot : 0.f;
  LDS float* xb = (LDS float*)shm;
  if (map == 1 && active) {
#pragma unroll
    for (int dt = 0; dt < 4; ++dt)
#pragma unroll
      for (int g = 0; g < 16; ++g) xb[(rg * 64 + dt * 16 + g) * 64 + lane] = O[dt][g] * inv_l;
  }
  __syncthreads();
  if (map == 0 && active) {
    const float lam = p->lam[l];
    float ss = 0.f;
#pragma unroll
    for (int dt = 0; dt < 4; ++dt)
#pragma unroll
      for (int g = 0; g < 16; ++g) { const float o = O[dt][g] * inv_l - lam * xb[(rg * 64 + dt * 16 + g) * 64 + lane]; O[dt][g] = o; ss += o * o; }
    ss += __shfl_xor(ss, 32);
    const float rs = rsqrtf(ss * (1.0f / 128.0f) + 1e-5f) * (1.0f - p->lam_init[l]);
#pragma unroll
    for (int dt = 0; dt < 4; ++dt)
#pragma unroll
      for (int g4 = 0; g4 < 4; ++g4) {
        const int dv0 = dt * 32 + 8 * g4 + 4 * hh;
        const f32x4 gs = gsv[dt * 4 + g4];
        const u32x2 ga = gav[dt * 4 + g4];
        const float o0 = O[dt][g4 * 4 + 0] * rs * gs[0] * siluf_(bflo(ga[0]));
        const float o1 = O[dt][g4 * 4 + 1] * rs * gs[1] * siluf_(bfhi(ga[0]));
        const float o2 = O[dt][g4 * 4 + 2] * rs * gs[2] * siluf_(bflo(ga[1]));
        const float o3 = O[dt][g4 * 4 + 3] * rs * gs[3] * siluf_(bfhi(ga[1]));
        u32x2 o; o[0] = pk2(o0, o1); o[1] = pk2(o2, o3);
        *(u32x2*)(p->H + (long)qrow * DM + h * 128 + dv0) = o;
      }
  }
}

constexpr int STG2 = 32768;
DI void attn_prompt_unit(KP p, int l, int b, int h, int qb, LDS char* shm) {
  const int tid = launder(threadIdx.x), wid = __builtin_amdgcn_readfirstlane(tid >> 6), lane = tid & 63, rg = wid & 3, map = wid >> 2, r = lane & 31, hh = lane >> 5;
  const int rowbase = b * 2048;
  const int nt = 2 * qb + 2;
  const int my_nt = 2 * qb + 1 + (rg >> 1);
  const int qrow = rowbase + qb * 128 + rg * 32 + r;
  bf16x8 qf[4];
#pragma unroll
  for (int t4 = 0; t4 < 4; ++t4) qf[t4] = __builtin_nontemporal_load((const bf16x8*)(p->Z + (long)qrow * INC + h * 128 + map * 64 + 16 * t4 + 8 * hh));
  const bf16_t* src[4];
#pragma unroll
  for (int i = 0; i < 4; ++i) {
    const int c = wid + 8 * i, rr = 8 * (c & 7) + (lane >> 3) + ((i >= 2) ? 64 * ((c - 16) >> 3) : 0);
    const int sc = (lane & 7) ^ ((rr >> 1) & 7);
    if (i < 2) src[i] = p->Kc + ((long)((b * 4 + h) * 2 + (c >> 3)) * 2048 + rr) * 64 + sc * 8;
    else src[i] = p->Vt + ((long)(b * 4 + h) * 32 * 128 + rr) * 64 + sc * 8;
  }
  auto issue = [&](int t, int stg) {
#pragma unroll
    for (int i = 0; i < 4; ++i) {
      const bf16_t* g = (i < 2) ? src[i] + t * 4096 : src[i] + t * 8192;
      __builtin_amdgcn_global_load_lds((const unsigned*)g, (LDS unsigned*)(shm + stg * STG2 + (wid + 8 * i) * 1024), 16, 0, 0);
    }
  };
  f32x16 O[4];
#pragma unroll
  for (int dt = 0; dt < 4; ++dt)
#pragma unroll
    for (int g = 0; g < 16; ++g) O[dt][g] = 0.f;
  float m_run = -1e30f, l_run = 0.f;
  const float cscale = 0.125f * 1.44269504089f;
  const int pr = permk(r);
  const int kx = (pr >> 1) & 7, vx = (r >> 1) & 7;
  issue(0, 0);
  if (nt > 1) issue(1, 1);
  if (nt > 1) asm volatile("s_waitcnt vmcnt(4)" ::: "memory"); else asm volatile("s_waitcnt vmcnt(0)" ::: "memory");
  __builtin_amdgcn_s_barrier();
  int b0 = 0, b1 = 1, b2 = 2;
  for (int t = 0; t < nt; ++t) {
    if (t + 2 < nt) issue(t + 2, b2);
    if (t < my_nt) {
      const LDS char* ks = shm + b0 * STG2 + map * 8192;
      const LDS char* vs = shm + b0 * STG2 + 16384;
      f32x16 X0, X1;
#pragma unroll
      for (int g = 0; g < 16; ++g) { X0[g] = 0.f; X1[g] = 0.f; }
#pragma unroll
      for (int t4 = 0; t4 < 4; ++t4) {
        const bf16x8 k0 = *(const LDS bf16x8*)(ks + pr * 128 + (((2 * t4 + hh) ^ kx) << 4));
        const bf16x8 k1 = *(const LDS bf16x8*)(ks + (32 + pr) * 128 + (((2 * t4 + hh) ^ kx) << 4));
        X0 = __builtin_amdgcn_mfma_f32_32x32x16_bf16(k0, qf[t4], X0, 0, 0, 0);
        X1 = __builtin_amdgcn_mfma_f32_32x32x16_bf16(k1, qf[t4], X1, 0, 0, 0);
      }
      float mx = X0[0];
#pragma unroll
      for (int g = 1; g < 16; ++g) mx = fmaxf(mx, X0[g]);
#pragma unroll
      for (int g = 0; g < 16; ++g) mx = fmaxf(mx, X1[g]);
      mx = xhalf_max(mx);
      const bool need = (mx - m_run) * cscale > 8.0f;
      float alpha = 1.0f;
      if (__any(need)) {
        const float mnew = fmaxf(m_run, mx);
        alpha = __builtin_amdgcn_exp2f((m_run - mnew) * cscale);
        m_run = mnew;
#pragma unroll
        for (int dt = 0; dt < 4; ++dt)
#pragma unroll
          for (int g = 0; g < 16; ++g) O[dt][g] *= alpha;
      }
      const float mc = m_run * cscale;
      float ls = 0.f;
#pragma unroll
      for (int g = 0; g < 16; ++g) { X0[g] = __builtin_amdgcn_exp2f(X0[g] * cscale - mc); ls += X0[g]; }
#pragma unroll
      for (int g = 0; g < 16; ++g) { X1[g] = __builtin_amdgcn_exp2f(X1[g] * cscale - mc); ls += X1[g]; }
      l_run = l_run * alpha + ls;
      bf16x8 pb[2][2];
#pragma unroll
      for (int s = 0; s < 2; ++s) {
        u32x4 a, c;
#pragma unroll
        for (int j = 0; j < 4; ++j) { a[j] = pk2(X0[8 * s + 2 * j], X0[8 * s + 2 * j + 1]); c[j] = pk2(X1[8 * s + 2 * j], X1[8 * s + 2 * j + 1]); }
        pb[0][s] = __builtin_bit_cast(bf16x8, a); pb[1][s] = __builtin_bit_cast(bf16x8, c);
      }
#pragma unroll
      for (int dt = 0; dt < 4; ++dt)
#pragma unroll
        for (int kh = 0; kh < 2; ++kh)
#pragma unroll
          for (int s = 0; s < 2; ++s) {
            const bf16x8 vf = *(const LDS bf16x8*)(vs + (dt * 32 + r) * 128 + (((kh * 4 + s * 2 + hh) ^ vx) << 4));
            O[dt] = __builtin_amdgcn_mfma_f32_32x32x16_bf16(vf, pb[kh][s], O[dt], 0, 0, 0);
          }
    }
    if (t + 2 < nt) asm volatile("s_waitcnt vmcnt(4)" ::: "memory"); else asm volatile("s_waitcnt vmcnt(0)" ::: "memory");
    asm volatile("s_waitcnt lgkmcnt(0)" ::: "memory");
    __builtin_amdgcn_s_barrier();
    { const int tb = b0; b0 = b1; b1 = b2; b2 = tb; }
  }
  u32x4 gav[8]; f32x4 gsv[16];
  if (map == 0) {
#pragma unroll
    for (int i = 0; i < 8; ++i) {
      const int dvb = (i >> 1) * 32 + 8 * (2 * (i & 1) + hh);
      gsv[2 * i] = *(const f32x4*)(p->g_subln + l * 128 + dvb);
      gsv[2 * i + 1] = *(const f32x4*)(p->g_subln + l * 128 + dvb + 4);
      gav[i] = __builtin_nontemporal_load((const u32x4*)(p->Z + (long)qrow * INC + 1536 + h * 128 + dvb));
    }
  }
  const float ltot = xhalf_sum(l_run);
  const float inv_l = 1.0f / ltot;
  LDS float* xb = (LDS float*)shm;
  if (map == 1) {
#pragma unroll
    for (int dt = 0; dt < 4; ++dt)
#pragma unroll
      for (int g = 0; g < 16; ++g) xb[(rg * 64 + dt * 16 + g) * 64 + lane] = O[dt][g] * inv_l;
  }
  __syncthreads();
  if (map == 0) {
    const float lam = p->lam[l];
    float ss = 0.f;
#pragma unroll
    for (int dt = 0; dt < 4; ++dt)
#pragma unroll
      for (int g = 0; g < 16; ++g) { const float o = O[dt][g] * inv_l - lam * xb[(rg * 64 + dt * 16 + g) * 64 + lane]; O[dt][g] = o; ss += o * o; }
    ss = xhalf_sum(ss);
    const float rs = rsqrtf(ss * (1.0f / 128.0f) + 1e-5f) * (1.0f - p->lam_init[l]);
#pragma unroll
    for (int dt = 0; dt < 4; ++dt)
#pragma unroll
      for (int kp = 0; kp < 2; ++kp) {
        const int i = dt * 2 + kp, dvb = dt * 32 + 8 * (2 * kp + hh);
        f32x4 av, bv;
#pragma unroll
        for (int j = 0; j < 4; ++j) {
          const auto sw = __builtin_amdgcn_permlane32_swap(__float_as_uint(O[dt][8 * kp + j] * rs), __float_as_uint(O[dt][8 * kp + 4 + j] * rs), false, false);
          av[j] = __uint_as_float(sw[0]); bv[j] = __uint_as_float(sw[1]);
        }
        const f32x4 g0 = gsv[2 * i], g1 = gsv[2 * i + 1];
        const u32x4 ga = gav[i];
        u32x4 o;
        o[0] = pk2(av[0] * g0[0] * siluf_(bflo(ga[0])), av[1] * g0[1] * siluf_(bfhi(ga[0])));
        o[1] = pk2(av[2] * g0[2] * siluf_(bflo(ga[1])), av[3] * g0[3] * siluf_(bfhi(ga[1])));
        o[2] = pk2(bv[0] * g1[0] * siluf_(bflo(ga[2])), bv[1] * g1[1] * siluf_(bfhi(ga[2])));
        o[3] = pk2(bv[2] * g1[2] * siluf_(bflo(ga[3])), bv[3] * g1[3] * siluf_(bfhi(ga[3])));
        *(u32x4*)(p->H + (long)qrow * DM + h * 128 + dvb) = o;
      }
  }
}

DI void conv_unit(KP p, int l, int cu, LDS char* shm) {
  const int tid = launder(threadIdx.x), lane = tid & 63, wid = tid >> 6;
  const bool smp = cu >= 1024;
  const int b = smp ? cu - 1024 : cu >> 5, t0 = smp ? 0 : (cu & 31) * 64;
  const int rowbase = smp ? MP + b * 64 : b * 2048, S = smp ? 64 : 2048;
  const int c = tid;
  float w[31], win[32];
#pragma unroll
  for (int j = 0; j < 31; ++j) w[j] = p->w_dw[(l * 31 + j) * 512 + c];
#pragma unroll
  for (int j = 0; j < 32; ++j) win[j] = 0.f;
  const float bias = p->b_dw[l * 512 + c];
  LDS float* ct = (LDS float*)shm;
  float* cso = p->out + (smp ? OFF_CS + (long)(l * 16 + b) * 30 * 512 : OFF_CP + (long)(l * 32 + b) * 30 * 512);
  const bf16_t* zb = p->Z + (long)rowbase * INC + 2048;
#pragma unroll 1
  for (int base = 0; base < 96; base += 32) {
    float un[32];
#pragma unroll
    for (int k = 0; k < 32; ++k) un[k] = 0.f;
    if (smp && base == 0) {
#pragma unroll
      for (int k = 0; k < 30; ++k) un[k] = p->state_conv[((long)(l * 16 + b) * 30 + k) * 512 + c];
    }
    bf16_t ra[32], rb[32];
#pragma unroll
    for (int k = 0; k < 32; ++k) {
      const int tau = t0 - 30 + base + k;
      const int tc = tau < 0 ? 0 : (tau > S - 1 ? S - 1 : tau);
      const bf16_t* zr = zb + (long)tc * INC;
      ra[k] = __builtin_nontemporal_load(zr + c); rb[k] = smp ? zr[512 + c] : (bf16_t)0;
    }
    __builtin_amdgcn_sched_barrier(0);
#pragma unroll
    for (int k = 0; k < 32; ++k) {
      const int tau = t0 - 30 + base + k;
      const float u = smp ? bf1(ra[k]) * sigmoidf_(bf1(rb[k])) : bf1(ra[k]);
      un[k] = (tau >= 0) ? u : un[k];
    }
    if (smp && base == 64 && t0 + 64 == S) {
#pragma unroll
      for (int k = 0; k < 30; ++k) cso[(long)k * 512 + c] = un[k];
    }
#pragma unroll
    for (int k = 0; k < 32; ++k) {
      const int ti = base + k;
      win[k] = un[k];
      float a = bias;
#pragma unroll
      for (int j = 0; j < 31; ++j) a += w[j] * win[(k + 2 + j) & 31];
      if (ti >= 30 && ti < 94) ct[(ti - 30) * 512 + c] = a;
    }
  }
  __syncthreads();
  for (int tt = wid; tt < 64; tt += 8) {
    const long row = rowbase + t0 + tt;
    const f32x4 a0 = *(const LDS f32x4*)(ct + tt * 512 + lane * 8);
    const f32x4 a1 = *(const LDS f32x4*)(ct + tt * 512 + lane * 8 + 4);
    float s = (a0[0] + a0[1]) + (a0[2] + a0[3]) + (a1[0] + a1[1]) + (a1[2] + a1[3]);
    s = wave_sum(s);
    const float mean = s * (1.0f / 512.0f);
    const f32x4 d0 = a0 - mean, d1 = a1 - mean;
    float q = d0[0] * d0[0] + d0[1] * d0[1] + d0[2] * d0[2] + d0[3] * d0[3] + d1[0] * d1[0] + d1[1] * d1[1] + d1[2] * d1[2] + d1[3] * d1[3];
    q = wave_sum(q);
    const float rstd = rsqrtf(q * (1.0f / 512.0f) + 1e-5f);
    const u32x4 gc = __builtin_nontemporal_load((const u32x4*)(p->Z + row * INC + 3072 + lane * 8));
    const f32x4 g0 = *(const f32x4*)(p->g_ln + l * 512 + lane * 8), g1 = *(const f32x4*)(p->g_ln + l * 512 + lane * 8 + 4);
    const f32x4 b0 = *(const f32x4*)(p->b_ln + l * 512 + lane * 8), b1 = *(const f32x4*)(p->b_ln + l * 512 + lane * 8 + 4);
    const f32x4 y0 = d0 * rstd * g0 + b0, y1 = d1 * rstd * g1 + b1;
    u32x4 o;
    o[0] = pk2(siluf_(y0[0]) * siluf_(bflo(gc[0])), siluf_(y0[1]) * siluf_(bfhi(gc[0])));
    o[1] = pk2(siluf_(y0[2]) * siluf_(bflo(gc[1])), siluf_(y0[3]) * siluf_(bfhi(gc[1])));
    o[2] = pk2(siluf_(y1[0]) * siluf_(bflo(gc[2])), siluf_(y1[1]) * siluf_(bfhi(gc[2])));
    o[3] = pk2(siluf_(y1[2]) * siluf_(bflo(gc[3])), siluf_(y1[3]) * siluf_(bfhi(gc[3])));
    *(u32x4*)(p->H + row * DM + 512 + lane * 8) = o;
  }
}

DI void phase_mix(KP p, int l, LDS char* shm, int ci) {
  const int tid = launder(threadIdx.x);
  if (gridDim.x == 256) {
    const int xcd = blockIdx.x & 7, cq = blockIdx.x >> 3, which = cq >> 4, qi = cq & 15;
#pragma unroll 1
    for (int r = 0; r < 8; ++r) {
      const int bb = 4 * xcd + (r >> 1), hd = 2 * (r & 1) + which;
      const int qb = (r & 1) ? 15 - qi : qi;
      attn_prompt_unit(launder_p(p), l, bb, hd, qb, shm);
      __syncthreads();
    }
  } else {
#pragma unroll 1
    for (int u = blockIdx.x; u < N_ATT_P; u += gridDim.x) {
      attn_prompt_unit(launder_p(p), l, (u & 127) >> 2, u & 3, 15 - (u >> 7), shm);
      __syncthreads();
    }
  }
  for (;;) {
    if (tid == 0) *(LDS volatile int*)(shm + QOFF) = (int)atomicAdd(p->ctr + ci, 1u);
    __syncthreads();
    const int it = *(LDS volatile int*)(shm + QOFF);
    __syncthreads();
    if (it >= N_ATT_S + N_CONV) break;
    p = launder_p(p);
    if (it < N_ATT_S) attn_unit<true>(p, l, it >> 2, it & 3, 0, shm);
    else conv_unit(p, l, it - N_ATT_S, shm);
    __syncthreads();
  }
}

#define XB_TMO      128
#define XB_XCNT(j)  (256  + 64 * (j))
#define XB_XSUB(j)  (1280 + 64 * (j))
#define XB_XGEN(j)  (2304 + 64 * (j))
#define XB_TOP      3328
#define XB_TOPGEN   3392
#define XCD_BAR_WORDS 3456
#define XB_SPIN_CAP (1u << 18)

__device__ __forceinline__ unsigned xb_ld(unsigned* p)              { return __hip_atomic_load(p, __ATOMIC_RELAXED, __HIP_MEMORY_SCOPE_AGENT); }
__device__ __forceinline__ unsigned xb_add(unsigned* p, unsigned v) { return __hip_atomic_fetch_add(p, v, __ATOMIC_RELAXED, __HIP_MEMORY_SCOPE_AGENT); }
__device__ __forceinline__ unsigned xb_xcc_id() { return (unsigned)__builtin_amdgcn_s_getreg((3 << 11) | 20) & 0xFu; }
#define XB_SPIN(cond, bar) do { unsigned _sp = 0; while (cond) { __builtin_amdgcn_s_sleep(1); \
    if ((++_sp & 255u) == 0u) { if (xb_ld(&(bar)[XB_TMO])) break; if (_sp > XB_SPIN_CAP) { atomicAdd(&(bar)[XB_TMO], 1u); break; } } } } while (0)

struct XcdBarrier {
    unsigned* bar; unsigned x;
    volatile LDS unsigned* st;
};

__device__ __forceinline__ XcdBarrier xcd_barrier_post(unsigned* bar, volatile LDS unsigned* st) {
    XcdBarrier b; b.bar = bar; b.x = xb_xcc_id(); b.st = st;
    if (threadIdx.x == 0) (void)xb_add(&bar[XB_XCNT(b.x)], 1u);
    return b;
}
__device__ __forceinline__ void xcd_barrier_complete(unsigned* bar, unsigned x, unsigned& nloc, unsigned& nx) {
    const unsigned G = gridDim.x * gridDim.y * gridDim.z;
    unsigned sum, cnt, mine, sp = 0u;
    for (;;) {
        sum = 0u; cnt = 0u; mine = 0u;
#pragma unroll
        for (unsigned j = 0; j < 16; ++j) { const unsigned c = xb_ld(&bar[XB_XCNT(j)]); sum += c; cnt += (c > 0u) ? 1u : 0u; mine = (j == x) ? c : mine; }
        if (sum == G) break;
        __builtin_amdgcn_s_sleep(1);
        if ((++sp & 255u) == 0u) { if (xb_ld(&bar[XB_TMO])) break; if (sp > XB_SPIN_CAP) { atomicAdd(&bar[XB_TMO], 1u); break; } }
    }
    nloc = mine > 0u ? mine : 1u; nx = cnt > 0u ? cnt : 1u;
}

__device__ __forceinline__ void xcd_barrier(const XcdBarrier& b) {
    asm volatile("s_waitcnt vmcnt(0)" ::: "memory");
    __syncthreads();
    if (threadIdx.x == 0) {
        unsigned* bar = b.bar;
        __builtin_amdgcn_s_waitcnt(0);
        unsigned nloc = b.st[0], nx = b.st[1];
        if (nloc == 0u) { xcd_barrier_complete(bar, b.x, nloc, nx); b.st[0] = nloc; b.st[1] = nx; }
        const unsigned old = xb_add(&bar[XB_XSUB(b.x)], 1u);
        const unsigned gen = old / nloc;
        if (old + 1u == (gen + 1u) * nloc) {
            __builtin_amdgcn_fence(__ATOMIC_RELEASE, "agent");
            asm volatile("s_waitcnt vmcnt(0)" ::: "memory");
            const unsigned og = xb_add(&bar[XB_TOP], 1u);
            const unsigned tg = og / nx;
            if (og + 1u == (tg + 1u) * nx) xb_add(&bar[XB_TOPGEN], 1u);
            else XB_SPIN(xb_ld(&bar[XB_TOPGEN]) == tg, bar);
            __builtin_amdgcn_fence(__ATOMIC_ACQUIRE, "agent");
            xb_add(&bar[XB_XGEN(b.x)], 1u);
            asm volatile("s_waitcnt vmcnt(0)" ::: "memory");
        } else {
            XB_SPIN(xb_ld(&bar[XB_XGEN(b.x)]) == gen, bar);
            __builtin_amdgcn_fence(__ATOMIC_ACQUIRE, "agent");
            asm volatile("s_waitcnt vmcnt(0)" ::: "memory");
        }
    }
    __syncthreads();
}

__global__ void __launch_bounds__(512, 2) mega_fwd(Params pv) {
  __shared__ __attribute__((aligned(1024))) char shm_[SHM_BYTES];
  LDS char* shm = (LDS char*)shm_;
  cg::grid_group grid = cg::this_grid();
  KP p0 = (KP)__builtin_amdgcn_kernarg_segment_ptr();
  if (p0->phase_lo == 777) grid.sync();
  volatile LDS unsigned* xst = (volatile LDS unsigned*)(shm + QOFF + 16);
  if (threadIdx.x == 0) { xst[0] = 0u; xst[1] = 0u; }
  __syncthreads();
  const XcdBarrier xb = xcd_barrier_post(p0->bar, xst);
  phase0(launder_p(p0), shm);              xcd_barrier(xb);
  phase_rows<0>(launder_p(p0));            xcd_barrier(xb);
  gemm_phase<0>(launder_p(p0), 0, shm);    xcd_barrier(xb);
#ifdef PROBE_GEMM
  gemm_phase<0>(launder_p(p0), 0, shm);    xcd_barrier(xb);
#endif
#ifdef PROBE_GEMM_NOEPI
  gemm_phase<2>(launder_p(p0), 0, shm);    xcd_barrier(xb);
#endif
#ifdef PROBE_GEMM_IN
  gemm_phase<0>(launder_p(p0), 0, shm);    xcd_barrier(xb);
#endif
  phase_mix(launder_p(p0), 0, shm, 0);        xcd_barrier(xb);
#ifdef PROBE_MIX
  phase_mix(launder_p(p0), 0, shm, 2);        xcd_barrier(xb);
#endif
  gemm_phase<1>(launder_p(p0), 0, shm);    xcd_barrier(xb);
#ifdef PROBE_GEMM
  gemm_phase<1>(launder_p(p0), 0, shm);    xcd_barrier(xb);
#endif
  phase_rows<1>(launder_p(p0));            xcd_barrier(xb);
  gemm_phase<0>(launder_p(p0), 1, shm);    xcd_barrier(xb);
  phase_mix(launder_p(p0), 1, shm, 1);        xcd_barrier(xb);
  gemm_phase<1>(launder_p(p0), 1, shm);    xcd_barrier(xb);
  phase_rows<2>(launder_p(p0));
}

extern "C" void kernel_launch(void* const* d_in, const int* in_sizes, int n_in, void* d_out, int out_size, void* d_ws, size_t ws_size, hipStream_t stream) {
  Params p{};
  const float* const* in = (const float* const*)d_in;
  p.x_p = in[0]; p.x_s = in[1]; p.c_p = in[2]; p.c_s = in[3]; p.cache_k = in[4]; p.cache_v = in[5]; p.state_conv = in[6];
  p.w_ada = in[7]; p.b_ada = in[8]; p.g_pre = in[9]; p.g_post = in[10]; p.w_in = in[11]; p.w_out = in[12];
  p.lq1 = in[13]; p.lk1 = in[14]; p.lq2 = in[15]; p.lk2 = in[16]; p.g_subln = in[17]; p.w_dw = in[18]; p.b_dw = in[19]; p.g_ln = in[20]; p.b_ln = in[21];
  p.out = (float*)d_out;
  char* ws = (char*)d_ws;
  size_t off = 0;
  auto take = [&](size_t bytes) { char* r = ws + off; off += (bytes + 1023) & ~(size_t)1023; return r; };
  p.ctr = (unsigned*)take(1024);
  p.bar = (unsigned*)take((size_t)XCD_BAR_WORDS * 4);
  p.lam = (float*)take(1024);
  p.rope = (f32x2*)take(2112 * 8 * 8);
  p.mod = (float*)take((size_t)2 * 48 * 3072 * 4);
  p.WtIn = (bf16_t*)take((size_t)2 * INC * 1024 * 2);
  p.WtOut = (bf16_t*)take((size_t)2 * 1024 * 1024 * 2);
  p.WtGluS = (bf16_t*)take((size_t)2 * 1024 * 1024 * 2);
  p.H = (bf16_t*)take((size_t)MT * 1024 * 2);
  p.Mo = (bf16_t*)take((size_t)MT * 1024 * 2);
  p.Z = (bf16_t*)take((size_t)MT * INC * 2);
  p.Vt = (bf16_t*)take((size_t)MP * 512 * 2);
  p.Kc = (bf16_t*)take((size_t)MP * 512 * 2);
  p.X1 = (bf16_t*)take((size_t)MT * 1024 * 2);
  for (int i = 0; i < 8; ++i) p.inv[i] = pow(500000.0, -(double)i / 8.0);
  for (int l = 0; l < 2; ++l) p.lam_init[l] = (float)(0.8 - 0.6 * exp(-0.3 * (double)l));
  p.phase_lo = 0; p.phase_hi = 9;
  static int grid_blocks = 0;
  if (!grid_blocks) {
    int dev = 0, cus = 0, per_cu = 0;
    hipGetDevice(&dev);
    hipDeviceGetAttribute(&cus, hipDeviceAttributeMultiprocessorCount, dev);
    hipOccupancyMaxActiveBlocksPerMultiprocessor(&per_cu, mega_fwd, 512, 0);
    if (per_cu < 1) per_cu = 1;
    grid_blocks = cus * 1;
    if (grid_blocks > 256) grid_blocks = 256;
  }
  hipMemsetAsync(p.bar, 0, (size_t)XCD_BAR_WORDS * 4, stream);
  void* args[] = {&p};
  hipError_t e = hipLaunchCooperativeKernel((void*)mega_fwd, dim3(grid_blocks), dim3(512), args, 0, stream);
  if (e != hipSuccess) fprintf(stderr, "cooperative launch failed: %s (grid %d)\n", hipGetErrorString(e), grid_blocks);
}
```

```cpp
#include <hip/hip_runtime.h>
#include <hip/hip_cooperative_groups.h>
#include <cstdio>
#include <cmath>
namespace cg = cooperative_groups;

typedef unsigned short bf16_t;
typedef short bf16x8 __attribute__((ext_vector_type(8)));
typedef float f32x4 __attribute__((ext_vector_type(4)));
typedef float f32x2 __attribute__((ext_vector_type(2)));
typedef float f32x16 __attribute__((ext_vector_type(16)));
typedef unsigned u32x2 __attribute__((ext_vector_type(2)));
typedef unsigned u32x4 __attribute__((ext_vector_type(4)));
typedef __bf16 bf16x2_t __attribute__((ext_vector_type(2)));
#define LDS __attribute__((address_space(3)))
#define DI __device__ __forceinline__

constexpr int DM = 1024, SEQ = 2048, DSQ = 64;
constexpr int MP = 32 * 2048, MS = 16 * 64, MT = MP + MS;
constexpr int INC = 3584;
constexpr long OFF_YP = 0, OFF_YS = 67108864L, OFF_KP = 68157440L, OFF_VP = 135266304L, OFF_CP = 202375168L,
               OFF_KS = 203358208L, OFF_VS = 204406784L, OFF_CS = 205455360L;
constexpr int SHM_BYTES = 131072 + 64 + 8 * 2304, QOFF = 131072, EPI_OFF = 131072 + 64;
constexpr int N_ATT_S = 64, N_ATT_P = 2048, N_CONV = 1040, N_MIX = N_ATT_S + N_ATT_P + N_CONV;

struct Params {
  const float *x_p, *x_s, *c_p, *c_s, *cache_k, *cache_v, *state_conv, *w_ada, *b_ada, *g_pre, *g_post, *w_in, *w_out,
      *lq1, *lk1, *lq2, *lk2, *g_subln, *w_dw, *b_dw, *g_ln, *b_ln;
  float* out;
  bf16_t *WtIn, *WtOut, *H, *Z, *Mo, *Vt, *Kc, *X1, *WtGluS;
  float *mod, *lam;
  f32x2* rope;
  unsigned* ctr;
  unsigned* bar;
  double inv[8];
  float lam_init[2];
  int phase_lo, phase_hi;
};

struct Params;
typedef const __attribute__((address_space(4))) Params* KP;
DI KP launder_p(KP q) { asm volatile("" : "+s"(q)); return q; }
DI int launder(int v) { asm volatile("" : "+v"(v)); return v; }
DI unsigned pk2(float a, float b) { f32x2 v = {a, b}; return __builtin_bit_cast(unsigned, __builtin_convertvector(v, bf16x2_t)); }
DI float bflo(unsigned u) { return __uint_as_float(u << 16); }
DI float bfhi(unsigned u) { return __uint_as_float(u & 0xffff0000u); }
DI float bf1(bf16_t u) { return __uint_as_float(((unsigned)u) << 16); }
DI float sigmoidf_(float x) { return __builtin_amdgcn_rcpf(1.0f + __builtin_amdgcn_exp2f(-1.44269504089f * x)); }
DI float siluf_(float x) { return x * sigmoidf_(x); }
DI float xhalf_max(float v) {
  const auto r = __builtin_amdgcn_permlane32_swap(__float_as_uint(v), __float_as_uint(v), false, false);
  return fmaxf(__uint_as_float(r[0]), __uint_as_float(r[1]));
}
DI float xhalf_sum(float v) {
  const auto r = __builtin_amdgcn_permlane32_swap(__float_as_uint(v), __float_as_uint(v), false, false);
  return __uint_as_float(r[0]) + __uint_as_float(r[1]);
}
DI float wave_sum(float v) {
  v += __shfl_xor(v, 32); v += __shfl_xor(v, 16); v += __shfl_xor(v, 8); v += __shfl_xor(v, 4); v += __shfl_xor(v, 2); v += __shfl_xor(v, 1);
  return v;
}

DI void sincos_d(double x, double& s, double& c) {
  const double kd = rint(x * 0.63661977236758134308);
  double r = fma(-kd, 1.57079632673412561417e+00, x);
  r = fma(-kd, 6.07710050650619224932e-11, r);
  const double r2 = r * r;
  double ps = 1.0 / 6227020800.0;
  ps = fma(ps, r2, -1.0 / 39916800.0); ps = fma(ps, r2, 1.0 / 362880.0); ps = fma(ps, r2, -1.0 / 5040.0);
  ps = fma(ps, r2, 1.0 / 120.0); ps = fma(ps, r2, -1.0 / 6.0);
  const double sn = fma(r * r2, ps, r);
  double pc = -1.0 / 87178291200.0;
  pc = fma(pc, r2, 1.0 / 479001600.0); pc = fma(pc, r2, -1.0 / 3628800.0); pc = fma(pc, r2, 1.0 / 40320.0);
  pc = fma(pc, r2, -1.0 / 720.0); pc = fma(pc, r2, 1.0 / 24.0); pc = fma(pc, r2, -0.5);
  const double cs = fma(pc, r2, 1.0);
  const int q = ((int)kd) & 3;
  s = (q == 0) ? sn : (q == 1) ? cs : (q == 2) ? -sn : -cs;
  c = (q == 0) ? cs : (q == 1) ? -sn : (q == 2) ? -cs : sn;
}

DI void mod_item(KP p, int it, LDS char* shm) {
  const int tid = launder(threadIdx.x);
  const int l = it / 72, rem = it % 72, nchunk = rem / 3, bg = rem % 3;
  LDS float* sc = (LDS float*)shm;
  LDS float* red = (LDS float*)(shm + 65536);
  for (int e = tid; e < 16384; e += 512) {
    const int k = e & 1023, bb = e >> 10;
    const float cv = (bg < 2) ? p->c_p[(bg * 16 + bb) * 1024 + k] : p->c_s[bb * 1024 + k];
    sc[k * 16 + bb] = siluf_(cv);
  }
  __syncthreads();
  const int col = tid & 127, kq = tid >> 7, n = nchunk * 128 + col;
  float acc[16];
#pragma unroll
  for (int i = 0; i < 16; ++i) acc[i] = 0.f;
  const float* wp = p->w_ada + ((long)l * 1024 + kq * 256) * 3072 + n;
#pragma unroll 4
  for (int k = 0; k < 256; ++k) {
    const float w = wp[(long)k * 3072];
    const LDS f32x4* s4 = (const LDS f32x4*)(sc + (kq * 256 + k) * 16);
#pragma unroll
    for (int q = 0; q < 4; ++q) { const f32x4 s = s4[q]; acc[q * 4 + 0] += s[0] * w; acc[q * 4 + 1] += s[1] * w; acc[q * 4 + 2] += s[2] * w; acc[q * 4 + 3] += s[3] * w; }
  }
#pragma unroll
  for (int i = 0; i < 16; ++i) red[(kq * 16 + i) * 128 + col] = acc[i];
  __syncthreads();
  for (int e = tid; e < 2048; e += 512) {
    const int bb = e >> 7, cc = e & 127, nn = nchunk * 128 + cc;
    const float v = red[(0 * 16 + bb) * 128 + cc] + red[(1 * 16 + bb) * 128 + cc] + red[(2 * 16 + bb) * 128 + cc] + red[(3 * 16 + bb) * 128 + cc] + p->b_ada[l * 3072 + nn];
    p->mod[((long)(l * 48 + bg * 16 + bb)) * 3072 + nn] = v;
  }
}

DI void misc_item(KP p) {
  const int tid = launder(threadIdx.x);
  for (int e = tid; e < 2112 * 8; e += 512) {
    const int pos = e >> 3, i = e & 7;
    double s, c; sincos_d((double)pos * p->inv[i], s, c);
    f32x2 v = {(float)c, (float)s};
    p->rope[e] = v;
  }
  if (tid < 2) {
    const int l = tid;
    float s1 = 0.f, s2 = 0.f;
    for (int d = 0; d < 64; ++d) { s1 += p->lq1[l * 64 + d] * p->lk1[l * 64 + d]; s2 += p->lq2[l * 64 + d] * p->lk2[l * 64 + d]; }
    p->lam[l] = expf(s1) - expf(s2) + p->lam_init[l];
    p->ctr[l] = 0u; p->ctr[l + 2] = 0u;
  }
}

DI void transpose_item(KP p, int idx, LDS char* shm) {
  const int tid = launder(threadIdx.x);
  const float* src; bf16_t* dst; int ldn, kt, nt;
  int ncol = -1;
  if (idx < 1792) { const int l = idx / 896, r = idx % 896; kt = r / 56; nt = r % 56; src = p->w_in + (long)l * 1024 * 3584; ldn = 3584; dst = p->WtIn + (long)l * 3584 * 1024;
    const int n0 = nt * 64; if (n0 >= 2048 && n0 < 3072) { const int t = (n0 - 2048) >> 8, w = (n0 - 2048) & 255; ncol = (w < 128) ? 2048 + 128 * t + w : 2560 + 128 * t + (w - 128); } }
  else if (idx >= 2304) { idx -= 2304; const int l = idx / 256, r = idx % 256; kt = r / 16; nt = r % 16; src = p->w_in + (long)l * 1024 * 3584; ldn = 3584; dst = p->WtGluS + (long)l * 1024 * 1024; ncol = 2048 + nt * 64; }
  else { idx -= 1792; const int l = idx / 256, r = idx % 256; kt = r / 16; nt = r % 16; src = p->w_out + (long)l * 1024 * 1024; ldn = 1024; dst = p->WtOut + (long)l * 1024 * 1024; }
  LDS float* tile = (LDS float*)shm;
#pragma unroll
  for (int i = 0; i < 2; ++i) {
    const int kk = (tid >> 4) + 32 * i, n4 = (tid & 15) * 4;
    const f32x4 v = *(const f32x4*)(src + (long)(kt * 64 + kk) * ldn + (ncol >= 0 ? ncol : nt * 64) + n4);
    tile[kk * 65 + n4 + 0] = v[0]; tile[kk * 65 + n4 + 1] = v[1]; tile[kk * 65 + n4 + 2] = v[2]; tile[kk * 65 + n4 + 3] = v[3];
  }
  __syncthreads();
  const int nn = tid >> 3, k8 = (tid & 7) * 8;
  u32x4 o;
  o[0] = pk2(tile[(k8 + 0) * 65 + nn], tile[(k8 + 1) * 65 + nn]);
  o[1] = pk2(tile[(k8 + 2) * 65 + nn], tile[(k8 + 3) * 65 + nn]);
  o[2] = pk2(tile[(k8 + 4) * 65 + nn], tile[(k8 + 5) * 65 + nn]);
  o[3] = pk2(tile[(k8 + 6) * 65 + nn], tile[(k8 + 7) * 65 + nn]);
  *(u32x4*)(dst + (long)(nt * 64 + nn) * 1024 + kt * 64 + k8) = o;
}

DI void phase0(KP p, LDS char* shm) {
  constexpr int N_MOD = 144, N_TR = 2304 + 512;
  for (int it = blockIdx.x; it < N_MOD + 1 + N_TR; it += gridDim.x) {
    p = launder_p(p);
    if (it < N_MOD) mod_item(p, it, shm);
    else if (it == N_MOD) misc_item(p);
    else transpose_item(p, it - N_MOD - 1, shm);
    __syncthreads();
  }
}

template <int MODE, int R>
DI void rows_body(KP p, int row0, int lane) {
  constexpr int lpre = (MODE == 0) ? 0 : 1;
  constexpr int lpost = (MODE == 1) ? 0 : 1;
  {
    const bool smp = row0 >= MP;
    const int b48 = smp ? 32 + ((row0 - MP) >> 6) : (row0 >> 11);
    const float* xin = smp ? p->x_s + (long)(row0 - MP) * 1024 : p->x_p + (long)row0 * 1024;
    float* xo = p->out + (smp ? OFF_YS + (long)(row0 - MP) * 1024 : OFF_YP + (long)row0 * 1024);
    const float* xs = (MODE == 2) ? xo : xin;
    f32x4 x[R][4];
    u32x2 mu[R][4];
    if (MODE == 2) {
#pragma unroll
      for (int r = 0; r < R; ++r)
#pragma unroll
        for (int i = 0; i < 4; ++i) {
          const u32x2 u = __builtin_nontemporal_load((const u32x2*)(p->X1 + (long)(row0 + r) * 1024 + lane * 4 + 256 * i));
          x[r][i][0] = bflo(u[0]); x[r][i][1] = bfhi(u[0]); x[r][i][2] = bflo(u[1]); x[r][i][3] = bfhi(u[1]);
        }
    } else {
#pragma unroll
      for (int r = 0; r < R; ++r)
#pragma unroll
        for (int i = 0; i < 4; ++i) x[r][i] = __builtin_nontemporal_load((const f32x4*)(xs + r * 1024 + lane * 4 + 256 * i));
    }
    if (MODE >= 1) {
#pragma unroll
      for (int r = 0; r < R; ++r)
#pragma unroll
        for (int i = 0; i < 4; ++i) mu[r][i] = __builtin_nontemporal_load((const u32x2*)(p->Mo + (long)(row0 + r) * 1024 + lane * 4 + 256 * i));
      const float* md = p->mod + (long)(lpost * 48 + b48) * 3072 + 2048;
      f32x4 gg[4];
#pragma unroll
      for (int i = 0; i < 4; ++i) gg[i] = *(const f32x4*)(md + lane * 4 + 256 * i) * *(const f32x4*)(p->g_post + lpost * 1024 + lane * 4 + 256 * i);
#pragma unroll
      for (int r = 0; r < R; ++r) {
        f32x4 m[4]; float ss = 0.f;
#pragma unroll
        for (int i = 0; i < 4; ++i) {
          const u32x2 u = mu[r][i];
          m[i][0] = bflo(u[0]); m[i][1] = bfhi(u[0]); m[i][2] = bflo(u[1]); m[i][3] = bfhi(u[1]);
          ss += m[i][0] * m[i][0] + m[i][1] * m[i][1] + m[i][2] * m[i][2] + m[i][3] * m[i][3];
        }
        ss = wave_sum(ss);
        const float rstd = rsqrtf(ss * (1.0f / 1024.0f) + 1e-6f);
#pragma unroll
        for (int i = 0; i < 4; ++i) x[r][i] = x[r][i] + gg[i] * (m[i] * rstd);
      }
#pragma unroll
      for (int r = 0; r < R; ++r)
#pragma unroll
        for (int i = 0; i < 4; ++i) {
          if (MODE == 2) *(f32x4*)(xo + r * 1024 + lane * 4 + 256 * i) = x[r][i];
          else { u32x2 o; o[0] = pk2(x[r][i][0], x[r][i][1]); o[1] = pk2(x[r][i][2], x[r][i][3]); *(u32x2*)(p->X1 + (long)(row0 + r) * 1024 + lane * 4 + 256 * i) = o; }
        }
    }
    if (MODE <= 1) {
      const float* md = p->mod + (long)(lpre * 48 + b48) * 3072;
      f32x4 sh[4], sg[4];
#pragma unroll
      for (int i = 0; i < 4; ++i) {
        sh[i] = *(const f32x4*)(md + lane * 4 + 256 * i);
        sg[i] = (*(const f32x4*)(md + 1024 + lane * 4 + 256 * i) + 1.0f) * *(const f32x4*)(p->g_pre + lpre * 1024 + lane * 4 + 256 * i);
      }
#pragma unroll
      for (int r = 0; r < R; ++r) {
        float ss = 0.f;
#pragma unroll
        for (int i = 0; i < 4; ++i) ss += x[r][i][0] * x[r][i][0] + x[r][i][1] * x[r][i][1] + x[r][i][2] * x[r][i][2] + x[r][i][3] * x[r][i][3];
        ss = wave_sum(ss);
        const float rstd = rsqrtf(ss * (1.0f / 1024.0f) + 1e-6f);
#pragma unroll
        for (int i = 0; i < 4; ++i) {
          const f32x4 hv = (x[r][i] * rstd) * sg[i] + sh[i];
          u32x2 o; o[0] = pk2(hv[0], hv[1]); o[1] = pk2(hv[2], hv[3]);
          *(u32x2*)(p->H + (long)(row0 + r) * 1024 + lane * 4 + 256 * i) = o;
        }
      }
    }
  }
}

template <int MODE>
DI void phase_rows(KP p) {
  const int tidr = launder(threadIdx.x), lane = tidr & 63, wid = tidr >> 6;
  const int gw = blockIdx.x * 8 + wid, nw = gridDim.x * 8;
  for (int row0 = gw * 4; row0 < MP; row0 += nw * 4) rows_body<MODE, 4>(p, row0, lane);
  for (int row0 = MP + gw; row0 < MT; row0 += nw) rows_body<MODE, 1>(p, row0, lane);
}

DI int lds_byte2(int r, int c) { const int st = (r >> 4) * 2 + (c >> 5), ob = (r & 15) * 64 + (c & 31) * 2; return st * 1024 + (ob ^ (((ob >> 9) & 1) << 5)); }
DI void stage_rc2(int b, int& R, int& C) { const int st = b >> 10, sb = b & 1023, swz = sb ^ (((sb >> 9) & 1) << 5); R = (st / 2) * 16 + swz / 64; C = (st % 2) * 32 + (swz % 64) / 2; }

template <int EPI, int MREP>
DI void gemm_tiles(KP p, int l, LDS char* shm) {
  constexpr int K = 1024, BK = 64, BM = 32 * MREP, TILE_A = BM * BK * 2, TILE_B = 256 * BK * 2, GLA = TILE_A / 8192, GLB = 4;
  constexpr int STAGE_B = 65536, N = (EPI != 1) ? INC : DM, nN = N / 256, WGM = 8;
  constexpr int row_lo = (MREP == 8) ? 0 : MP;
  constexpr int nM = (MREP == 8) ? MP / 256 : MS / 64, nwg = nM * nN;
  const bf16_t* A = p->H;
  const bf16_t* Bt = (EPI != 1) ? p->WtIn + (long)l * INC * 1024 : p->WtOut + (long)l * 1024 * 1024;
  const int tid = launder(threadIdx.x), wid = tid >> 6, lane = tid & 63, wr = wid >> 2, wc = wid & 3, fr = lane & 15, fq = lane >> 4;
  int sRa[GLA], sCa[GLA], sRb[GLB], sCb[GLB];
#pragma unroll
  for (int i = 0; i < GLA; ++i) stage_rc2(wid * 1024 + i * 8192 + lane * 16, sRa[i], sCa[i]);
#pragma unroll
  for (int i = 0; i < GLB; ++i) stage_rc2(wid * 1024 + i * 8192 + lane * 16, sRb[i], sCb[i]);
  auto tile_of = [&](int it, int& brow, int& bcol) -> bool {
    const long L = (long)it * gridDim.x + blockIdx.x;
    if (L >= nwg) return false;
    int wgid = (int)L;
    if (MREP == 8) {
      { const int q = nwg / 8, r = nwg % 8, xcd = wgid % 8, off = wgid / 8; wgid = (xcd < r ? xcd * (q + 1) : r * (q + 1) + (xcd - r) * q) + off; }
      const int nig = WGM * nN, gid = wgid / nig, fm = gid * WGM, gsz = (nM - fm) < WGM ? (nM - fm) : WGM;
      brow = row_lo + (fm + ((wgid % nig) % gsz)) * BM; bcol = ((wgid % nig) / gsz) * 256;
    } else {
      brow = row_lo + (wgid % nM) * BM; bcol = (wgid / nM) * 256;
    }
    return true;
  };
#define SA_(b) (shm + (b) * STAGE_B)
#define SB_(b) (shm + (b) * STAGE_B + 32768)
#define GLDS_STAGE_(buf, kt, Ab_, Bb_) do { _Pragma("unroll") for (int i = 0; i < GLA; ++i) \
      __builtin_amdgcn_global_load_lds((const unsigned*)((Ab_) + (long)sRa[i] * K + (kt) * BK + sCa[i]), (LDS unsigned*)(SA_(buf) + wid * 1024 + i * 8192), 16, 0, 0); \
    _Pragma("unroll") for (int i = 0; i < GLB; ++i) \
      __builtin_amdgcn_global_load_lds((const unsigned*)((Bb_) + (long)sRb[i] * K + (kt) * BK + sCb[i]), (LDS unsigned*)(SB_(buf) + wid * 1024 + i * 8192), 16, 0, 0); } while (0)
  int brow, bcol;
  bool have = tile_of(0, brow, bcol);
  if (have) {
    GLDS_STAGE_(0, 0, A + (long)brow * K, ((EPI != 1 && bcol >= 2048 && bcol < 3072 && MREP != 8) ? p->WtGluS + (long)l * 1024 * 1024 + (long)(bcol - 2048) * K : Bt + (long)bcol * K));
    asm volatile("s_waitcnt vmcnt(0)" ::: "memory");
    __syncthreads();
  }
  for (int it = 0; have; ++it) {
    int nbrow = 0, nbcol = 0;
    const bool have_next = tile_of(it + 1, nbrow, nbcol);
    const bf16_t* Ab = A + (long)brow * K;
    const bf16_t* Bb = (EPI != 1 && bcol >= 2048 && bcol < 3072 && MREP != 8) ? p->WtGluS + (long)l * 1024 * 1024 + (long)(bcol - 2048) * K : Bt + (long)bcol * K;
    const bf16_t* nAb = A + (long)nbrow * K;
    const bf16_t* nBb = (EPI != 1 && nbcol >= 2048 && nbcol < 3072 && MREP != 8) ? p->WtGluS + (long)l * 1024 * 1024 + (long)(nbcol - 2048) * K : Bt + (long)nbcol * K;
    f32x4 acc[MREP][4];
#pragma unroll
    for (int m = 0; m < MREP; ++m)
#pragma unroll
      for (int n = 0; n < 4; ++n) acc[m][n] = (f32x4){0.f, 0.f, 0.f, 0.f};
    constexpr int nt = K / BK;
    for (int t = 0; t < nt; ++t) {
      const int cur = t & 1;
      if (t + 1 < nt) GLDS_STAGE_(cur ^ 1, t + 1, Ab, Bb);
      else if (have_next) GLDS_STAGE_(0, 0, nAb, nBb);
#pragma unroll
      for (int ks = 0; ks < 2; ++ks) {
        bf16x8 At[MREP], Bf[4];
#pragma unroll
        for (int m = 0; m < MREP; ++m) At[m] = *(const LDS bf16x8*)(SA_(cur) + lds_byte2(wr * (BM / 2) + m * 16 + fr, ks * 32 + fq * 8));
#pragma unroll
        for (int n = 0; n < 4; ++n) Bf[n] = *(const LDS bf16x8*)(SB_(cur) + lds_byte2(wc * 64 + n * 16 + fr, ks * 32 + fq * 8));
#pragma unroll
        for (int m = 0; m < MREP; ++m)
#pragma unroll
          for (int n = 0; n < 4; ++n) acc[m][n] = __builtin_amdgcn_mfma_f32_16x16x32_bf16(Bf[n], At[m], acc[m][n], 0, 0, 0);
        __builtin_amdgcn_sched_barrier(0);
      }
      asm volatile("s_waitcnt vmcnt(0)" ::: "memory");
      __syncthreads();
    }
    if (EPI == 0) {
      const int kind = bcol >> 9;
      const bool smp = (MREP != 8);
      if (kind < 2) {
#pragma unroll
        for (int m = 0; m < MREP; ++m) {
          const int row = brow + wr * (BM / 2) + m * 16 + fr;
          const int pos = smp ? 2048 + ((row - MP) & 63) : (row & 2047);
          f32x4 v = acc[m][0];
          const f32x4 cs0 = *(const f32x4*)((const float*)p->rope + (pos * 8 + (fq & 1) * 4) * 2);
          const f32x4 cs1 = *(const f32x4*)((const float*)p->rope + (pos * 8 + (fq & 1) * 4) * 2 + 4);
          const float sg = (fq < 2) ? -1.0f : 1.0f;
          f32x4 pr;
          pr[0] = __shfl_xor(v[0], 32); pr[1] = __shfl_xor(v[1], 32); pr[2] = __shfl_xor(v[2], 32); pr[3] = __shfl_xor(v[3], 32);
          v[0] = v[0] * cs0[0] + sg * pr[0] * cs0[1];
          v[1] = v[1] * cs0[2] + sg * pr[1] * cs0[3];
          v[2] = v[2] * cs1[0] + sg * pr[2] * cs1[1];
          v[3] = v[3] * cs1[2] + sg * pr[3] * cs1[3];
          acc[m][0] = v;
        }
      }
#pragma unroll
      for (int m = 0; m < MREP; ++m) {
        const int row = brow + wr * (BM / 2) + m * 16 + fr;
#pragma unroll
        for (int n = 0; n < 4; ++n) {
          f32x4 v = acc[m][n];
          const int col = bcol + wc * 64 + n * 16 + fq * 4;
          u32x2 o; o[0] = pk2(v[0], v[1]); o[1] = pk2(v[2], v[3]);
          *(u32x2*)(p->Z + (long)row * INC + col) = o;
          if (kind == 1 || kind == 2) {
            float* dst = smp ? p->out + (kind == 1 ? OFF_KS : OFF_VS) + ((long)l * MS + (row - MP)) * 512 + (col - kind * 512)
                             : p->out + (kind == 1 ? OFF_KP : OFF_VP) + ((long)l * MP + row) * 512 + (col - kind * 512);
            *(f32x4*)dst = v;
          }
        }
      }
    } else if (EPI == 2) {
      float sacc = 0.f;
#pragma unroll
      for (int m = 0; m < MREP; ++m)
#pragma unroll
        for (int n = 0; n < 4; ++n) sacc += acc[m][n][0] + acc[m][n][1] + acc[m][n][2] + acc[m][n][3];
      if (sacc == 123456.789f) p->lam[8] = sacc;
    } else {
#pragma unroll
      for (int m = 0; m < MREP; ++m) {
        const int row = brow + wr * (BM / 2) + m * 16 + fr;
#pragma unroll
        for (int n = 0; n < 4; ++n) {
          const f32x4 v = acc[m][n];
          const int col = bcol + wc * 64 + n * 16 + fq * 4;
          u32x2 o; o[0] = pk2(v[0], v[1]); o[1] = pk2(v[2], v[3]);
          *(u32x2*)(p->Mo + (long)row * DM + col) = o;
        }
      }
    }
    have = have_next; brow = nbrow; bcol = nbcol;
  }
  __syncthreads();
}


namespace pg8 {
#define PG8_LAS __attribute__((address_space(3)))
typedef unsigned short bf16_t;
typedef short bf16x8 __attribute__((ext_vector_type(8)));
typedef float f32x4 __attribute__((ext_vector_type(4)));
constexpr int BM = 256, BK = 64, HALF = 128, HTB = HALF * BK * 2, STAGE_BYTES = 8 * HTB, NXCD = 8, WGM = 8;
__device__ __forceinline__ int lds_byte(int r, int c) { const int st = (r >> 4) * 2 + (c >> 5), rr = r & 15, cc = c & 31, ob = rr * 64 + cc * 2; return st * 1024 + (ob ^ (((ob >> 9) & 1) << 5)); }
__device__ __forceinline__ void stage_rc(int b, int& R, int& C) { const int st = b / 1024, sb = b % 1024, swz = sb ^ (((sb >> 9) & 1) << 5); R = (st >> 1) * 16 + swz / 64; C = (st & 1) * 32 + (swz % 64) / 2; }
__device__ __forceinline__ int perm32(int rho) { const int n = rho >> 4, i = rho & 15; return 8 * (i >> 2) + 4 * n + (i & 3); }
struct Unit { int pm, pn; };
struct Gemm { const bf16_t* A; const bf16_t* Bt; int M, N, K; };
struct StaticOrder {
    int nM, nN, nwg, G, c;
    __device__ void init(int M, int N, int G_, int c_) { nM = M / BM; nN = N / BM; nwg = nM * nN; G = G_; c = c_; }
    __device__ bool next(int i, Unit& u) const {
        const long L = (long)i * G + c; if (L >= nwg) return false;
        int wgid = (int)L; { const int q = nwg / NXCD, r = nwg % NXCD, xcd = wgid % NXCD, off = wgid / NXCD; wgid = (xcd < r ? xcd * (q + 1) : r * (q + 1) + (xcd - r) * q) + off; }
        const int nig = WGM * nN, gid = wgid / nig, fm = gid * WGM, gsz = (nM - fm) < WGM ? (nM - fm) : WGM;
        u.pm = fm + ((wgid % nig) % gsz); u.pn = (wgid % nig) / gsz; return true;
    }
    __device__ __forceinline__ void a_ready(const Unit&) const {}
    __device__ __forceinline__ void done(const Unit&) const {}
};
template <class Epi, class Sched, bool ALIGN_EPI = false, bool SP2 = false>
__device__ __forceinline__ void gemm_phase(PG8_LAS unsigned char* lds, const Gemm g, const Sched& S, const Epi& E) {
    const int tid = launder(threadIdx.x), wid = __builtin_amdgcn_readfirstlane(tid >> 6), lane = tid & 63, wr = wid >> 2, wc = wid & 3, fr = lane & 15, fq = lane >> 4;
    const int K = g.K, nt = K / BK;
    unsigned voffA[2], voffB[2];
#pragma unroll
    for (int i = 0; i < 2; ++i) { int R, C; stage_rc(tid * 16 + i * 8192, R, C); const int Rb = Epi::PERM ? ((R & ~31) + perm32(R & 31)) : R;
        voffA[i] = (unsigned)(R * K + C) * 2u; voffB[i] = (unsigned)(Rb * K + C) * 2u; }
    const size_t kstep = (size_t)(BK * 2);
    const size_t hstep = (size_t)HALF * K * 2;
    const size_t tstep = 2 * hstep;
    const unsigned ldsw = (unsigned)wid * 1024u;
    const int aoff = lds_byte(wr * 64 + fr, fq * 8), boff = lds_byte(wc * 32 + fr, fq * 8);
#define PG8_SA(b, h) (((b) * 2 + (h)) * HTB)
#define PG8_SB(b, h) ((4 + (b) * 2 + (h)) * HTB)
#define PG8_STAGE(bufoff, gbase, voff) do { _Pragma("unroll") for (int _i = 0; _i < 2; ++_i) \
        __builtin_amdgcn_global_load_lds((const unsigned*)((const char*)(gbase) + (voff)[_i]), (PG8_LAS unsigned*)(lds + (bufoff) + ldsw + _i * 8192), 16, 0, 0); } while (0)
#define PG8_LDA(dst, b, h) do { _Pragma("unroll") for (int m = 0; m < 4; ++m) _Pragma("unroll") for (int k = 0; k < 2; ++k) dst[m][k] = *(const PG8_LAS bf16x8*)(lds + PG8_SA(b, h) + aoff + m * 2048 + k * 1024); } while (0)
#define PG8_LDB(dst, b, h) do { _Pragma("unroll") for (int n = 0; n < 2; ++n) _Pragma("unroll") for (int k = 0; k < 2; ++k) dst[n][k] = *(const PG8_LAS bf16x8*)(lds + PG8_SB(b, h) + boff + n * 2048 + k * 1024); } while (0)
#define PG8_MMA(ai, bj, At, Bt) do { __builtin_amdgcn_s_setprio(1); _Pragma("unroll") for (int m = 0; m < 4; ++m) _Pragma("unroll") for (int n = 0; n < 2; ++n) _Pragma("unroll") for (int k = 0; k < 2; ++k) \
        acc[ai][bj][m][n] = __builtin_amdgcn_mfma_f32_16x16x32_bf16(Bt[n][k], At[m][k], acc[ai][bj][m][n], 0, 0, 0); __builtin_amdgcn_s_setprio(0); } while (0)
#define PG8_WAIT_V(n) asm volatile("s_waitcnt vmcnt(" #n ")" ::: "memory")
#define PG8_WAIT_L(n) asm volatile("s_waitcnt lgkmcnt(" #n ")" ::: "memory")
#define PG8_BAR __builtin_amdgcn_s_barrier()
#define PG8_SCHED __builtin_amdgcn_sched_barrier(0)
    Unit cur, nxt; int ui = 0;
    if (!S.next(0, cur)) return;
    f32x4 acc[2][2][4][2];
#pragma unroll
    for (int a = 0; a < 2; ++a)
#pragma unroll
        for (int b = 0; b < 2; ++b)
#pragma unroll
            for (int m = 0; m < 4; ++m)
#pragma unroll
                for (int n = 0; n < 2; ++n) acc[a][b][m][n] = (f32x4){0.f, 0.f, 0.f, 0.f};
    bf16x8 At[4][2], B0[2][2], B1[2][2];
    const char* cA = (const char*)g.A + (size_t)cur.pm * tstep; const char* cB = (const char*)g.Bt + (size_t)cur.pn * tstep;
    S.a_ready(cur);
    if constexpr (SP2) {
        PG8_STAGE(PG8_SB(0, 0), cB, voffB); PG8_STAGE(PG8_SB(0, 1), cB + hstep, voffB); PG8_STAGE(PG8_SA(0, 0), cA, voffA); PG8_STAGE(PG8_SA(0, 1), cA + hstep, voffA);
        if (wr == 1) PG8_BAR;
        PG8_WAIT_V(2); PG8_BAR;
        PG8_STAGE(PG8_SB(1, 0), cB + kstep, voffB); PG8_STAGE(PG8_SA(1, 0), cA + kstep, voffA); PG8_STAGE(PG8_SB(1, 1), cB + hstep + kstep, voffB);
        PG8_WAIT_V(6); PG8_BAR;
    } else {
        PG8_STAGE(PG8_SB(0, 0), cB, voffB); PG8_STAGE(PG8_SA(0, 0), cA, voffA); PG8_STAGE(PG8_SB(0, 1), cB + hstep, voffB); PG8_STAGE(PG8_SA(0, 1), cA + hstep, voffA);
        if (wr == 1) PG8_BAR;
        PG8_WAIT_V(4); PG8_BAR;
        PG8_STAGE(PG8_SB(1, 0), cB + kstep, voffB); PG8_STAGE(PG8_SA(1, 0), cA + kstep, voffA); PG8_STAGE(PG8_SB(1, 1), cB + hstep + kstep, voffB);
        PG8_WAIT_V(6); PG8_BAR;
    }
    for (;;) {
        const bool has_next = S.next(ui + 1, nxt);
        const char* nA = has_next ? (const char*)g.A + (size_t)nxt.pm * tstep : cA; const char* nB = has_next ? (const char*)g.Bt + (size_t)nxt.pn * tstep : cB;
        for (int t = 0; t < nt; t += 2) {
            const bool last = (t == nt - 2);
            const char* a1 = cA + (size_t)(t + 1) * kstep;
            const char* a2 = last ? nA : cA + (size_t)(t + 2) * kstep; const char* b2 = last ? nB : cB + (size_t)(t + 2) * kstep;
            const char* a3 = a2 + kstep; const char* b3 = b2 + kstep;
            if (last && has_next) S.a_ready(nxt);
            if constexpr (SP2) {
            PG8_LDB(B0, 0, 0); PG8_LDB(B1, 0, 1); PG8_SCHED; PG8_LDA(At, 0, 0); PG8_STAGE(PG8_SA(1, 1), a1 + hstep, voffA);
            PG8_WAIT_V(8); PG8_WAIT_L(0); PG8_BAR; PG8_MMA(0, 0, At, B0); PG8_MMA(0, 1, At, B1); PG8_BAR; PG8_SCHED;
            PG8_LDA(At, 0, 1); PG8_STAGE(PG8_SB(0, 0), b2, voffB); PG8_STAGE(PG8_SB(0, 1), b2 + hstep, voffB); PG8_STAGE(PG8_SA(0, 0), a2, voffA);
            PG8_WAIT_V(8); PG8_WAIT_L(0); PG8_BAR; PG8_MMA(1, 0, At, B0); PG8_MMA(1, 1, At, B1); PG8_BAR; PG8_SCHED;
            PG8_LDB(B0, 1, 0); PG8_LDB(B1, 1, 1); PG8_SCHED; PG8_LDA(At, 1, 0); PG8_STAGE(PG8_SA(0, 1), a2 + hstep, voffA);
            PG8_WAIT_V(8); PG8_WAIT_L(0); PG8_BAR; PG8_MMA(0, 0, At, B0); PG8_MMA(0, 1, At, B1); PG8_BAR; PG8_SCHED;
            PG8_LDA(At, 1, 1); PG8_STAGE(PG8_SB(1, 0), b3, voffB); PG8_STAGE(PG8_SB(1, 1), b3 + hstep, voffB); PG8_STAGE(PG8_SA(1, 0), a3, voffA);
            PG8_WAIT_V(8); PG8_WAIT_L(0); PG8_BAR; PG8_MMA(1, 0, At, B0); PG8_MMA(1, 1, At, B1); PG8_BAR; PG8_SCHED;
            } else {
            PG8_LDB(B0, 0, 0); PG8_SCHED; PG8_LDA(At, 0, 0); PG8_STAGE(PG8_SA(1, 1), a1 + hstep, voffA);
            PG8_WAIT_L(8); PG8_BAR; PG8_WAIT_L(0); PG8_MMA(0, 0, At, B0); PG8_BAR; PG8_SCHED;
            PG8_LDB(B1, 0, 1); PG8_STAGE(PG8_SB(0, 0), b2, voffB);
            PG8_BAR; PG8_WAIT_L(0); PG8_MMA(0, 1, At, B1); PG8_BAR;
            PG8_LDA(At, 0, 1); PG8_STAGE(PG8_SA(0, 0), a2, voffA);
            PG8_BAR; PG8_WAIT_L(0); PG8_MMA(1, 0, At, B0); PG8_BAR; PG8_SCHED;
            PG8_STAGE(PG8_SB(0, 1), b2 + hstep, voffB);
            PG8_WAIT_V(6); PG8_BAR; PG8_MMA(1, 1, At, B1); PG8_BAR;
            PG8_LDB(B0, 1, 0); PG8_SCHED; PG8_LDA(At, 1, 0); PG8_STAGE(PG8_SA(0, 1), a2 + hstep, voffA);
            PG8_WAIT_L(8); PG8_BAR; PG8_WAIT_L(0); PG8_MMA(0, 0, At, B0); PG8_BAR; PG8_SCHED;
            PG8_LDB(B1, 1, 1); PG8_STAGE(PG8_SB(1, 0), b3, voffB);
            PG8_BAR; PG8_WAIT_L(0); PG8_MMA(0, 1, At, B1); PG8_BAR;
            PG8_LDA(At, 1, 1); PG8_STAGE(PG8_SA(1, 0), a3, voffA);
            PG8_BAR; PG8_WAIT_L(0); PG8_MMA(1, 0, At, B0); PG8_BAR; PG8_SCHED;
            PG8_STAGE(PG8_SB(1, 1), b3 + hstep, voffB);
            PG8_WAIT_V(6); PG8_BAR; PG8_MMA(1, 1, At, B1); PG8_BAR;
            }
        }
        if constexpr (ALIGN_EPI) { if (wr == 0) PG8_BAR; }
        if constexpr (!Epi::AFTER_DRAIN) { E(acc, cur, wr, wc, fr, fq); S.done(cur); }
        if (!has_next) break;
#pragma unroll
        for (int a = 0; a < 2; ++a)
#pragma unroll
            for (int b = 0; b < 2; ++b)
#pragma unroll
                for (int m = 0; m < 4; ++m)
#pragma unroll
                    for (int n = 0; n < 2; ++n) acc[a][b][m][n] = (f32x4){0.f, 0.f, 0.f, 0.f};
        cur = nxt; cA = nA; cB = nB; ++ui;
        if constexpr (ALIGN_EPI) { if (wr == 1) PG8_BAR; }
    }
    PG8_WAIT_V(0);
    if constexpr (!ALIGN_EPI) { if (wr == 0) PG8_BAR; }
    PG8_BAR;
    if constexpr (Epi::AFTER_DRAIN) { E.fused(acc, cur, wr, wc, fr, fq, lds, wid, lane); S.done(cur); }
#undef PG8_SA
#undef PG8_SB
#undef PG8_STAGE
#undef PG8_LDA
#undef PG8_LDB
#undef PG8_MMA
#undef PG8_WAIT_V
#undef PG8_WAIT_L
#undef PG8_BAR
#undef PG8_SCHED
}
}

struct EpiIn {
  static constexpr bool PERM = true, AFTER_DRAIN = false;
  KP p; int l; LDS char* stg;
  DI void operator()(f32x4 (&acc)[2][2][4][2], const pg8::Unit& u, int wr, int wc, int fr_, int fq_) const {
    const int ln = launder((int)__lane_id()), fr = ln & 15, fq = ln >> 4;
    const int kind = u.pn >> 1;
    if (kind < 2 && (wc & 1) == 0) {
      const float sg = (fq == 0) ? -1.0f : 1.0f;
#pragma unroll
      for (int ai = 0; ai < 2; ++ai)
#pragma unroll
        for (int m = 0; m < 4; ++m) {
          const int row = u.pm * 256 + ai * 128 + wr * 64 + m * 16 + fr;
          const float* tb = (const float*)p->rope + (row & 2047) * 16;
          const f32x4 t0 = *(const f32x4*)tb, t1 = *(const f32x4*)(tb + 4), t2 = *(const f32x4*)(tb + 8), t3 = *(const f32x4*)(tb + 12);
#pragma unroll
          for (int bj = 0; bj < 2; ++bj) {
            f32x4 v0 = acc[ai][bj][m][0], v1 = acc[ai][bj][m][1], q0, q1;
#pragma unroll
            for (int j = 0; j < 4; ++j) { q0[j] = __shfl_xor(v0[j], 16); q1[j] = __shfl_xor(v1[j], 16); }
            f32x4 n0, n1;
            n0[0] = v0[0] * t0[0] + sg * q0[0] * t0[1]; n0[1] = v0[1] * t0[2] + sg * q0[1] * t0[3];
            n0[2] = v0[2] * t1[0] + sg * q0[2] * t1[1]; n0[3] = v0[3] * t1[2] + sg * q0[3] * t1[3];
            n1[0] = v1[0] * t2[0] + sg * q1[0] * t2[1]; n1[1] = v1[1] * t2[2] + sg * q1[1] * t2[3];
            n1[2] = v1[2] * t3[0] + sg * q1[2] * t3[1]; n1[3] = v1[3] * t3[2] + sg * q1[3] * t3[3];
            if (fq < 2) { acc[ai][bj][m][0] = n0; acc[ai][bj][m][1] = n1; }
          }
        }
    }
#pragma unroll
    for (int ai = 0; ai < 2; ++ai)
#pragma unroll
      for (int m = 0; m < 4; ++m) {
        const int row = u.pm * 256 + ai * 128 + wr * 64 + m * 16 + fr;
#pragma unroll
        for (int bj = 0; bj < 2; ++bj) {
          const f32x4 v0 = acc[ai][bj][m][0], v1 = acc[ai][bj][m][1];
          const int col = u.pn * 256 + bj * 128 + wc * 32 + 8 * fq;
          if (u.pn >= 8 && u.pn < 12) {
            if (bj == 0) {
              const f32x4 g0 = acc[ai][1][m][0], g1 = acc[ai][1][m][1];
              f32x4 u0, u1;
#pragma unroll
              for (int j = 0; j < 4; ++j) { u0[j] = v0[j] * sigmoidf_(g0[j]); u1[j] = v1[j] * sigmoidf_(g1[j]); }
              const int ch = 128 * (u.pn - 8) + wc * 32 + 8 * fq;
              u32x4 ou; ou[0] = pk2(u0[0], u0[1]); ou[1] = pk2(u0[2], u0[3]); ou[2] = pk2(u1[0], u1[1]); ou[3] = pk2(u1[2], u1[3]);
              *(u32x4*)(p->Z + (long)row * INC + 2048 + ch) = ou;
              const int sq = row & 2047;
              if (sq >= 2018) { float* d = p->out + OFF_CP + ((long)(l * 32 + (row >> 11)) * 30 + (sq - 2018)) * 512 + ch; *(f32x4*)d = u0; *(f32x4*)(d + 4) = u1; }
            }
            continue;
          }
          u32x4 o; o[0] = pk2(v0[0], v0[1]); o[1] = pk2(v0[2], v0[3]); o[2] = pk2(v1[0], v1[1]); o[3] = pk2(v1[2], v1[3]);
          if (kind == 1) {
            const int ck = col - 512;
            *(u32x4*)(p->Kc + ((long)((row >> 11) * 8 + (ck >> 6)) * 2048 + (row & 2047)) * 64 + (ck & 63)) = o;
          } else if (kind != 2) *(u32x4*)(p->Z + (long)row * INC + col) = o;
          else {
            LDS bf16_t* sb = (LDS bf16_t*)(stg + (wr * 4 + wc) * 2304);
#pragma unroll
            for (int j = 0; j < 4; ++j) {
              sb[(8 * fq + 2 * j) * 16 + fr] = (bf16_t)(o[j] & 0xffffu);
              sb[(8 * fq + 2 * j + 1) * 16 + fr] = (bf16_t)(o[j] >> 16);
            }
            const u32x4 tv = *(const LDS u32x4*)(sb + (ln >> 1) * 16 + (ln & 1) * 8);
            const int tok0 = u.pm * 256 + ai * 128 + wr * 64 + m * 16;
            const int cv = (u.pn - 4) * 256 + bj * 128 + wc * 32 + (ln >> 1);
            *(u32x4*)(p->Vt + (((long)((tok0 >> 11) * 4 + (cv >> 7)) * 32 + ((tok0 & 2047) >> 6)) * 128 + (cv & 127)) * 64 + (tok0 & 63) + (ln & 1) * 8) = tv;
          }
          if (kind == 1 || kind == 2) {
            LDS float* st = (LDS float*)(stg + (wr * 4 + wc) * 2304);
            *(LDS f32x4*)(st + fr * 36 + 8 * fq) = v0; *(LDS f32x4*)(st + fr * 36 + 8 * fq + 4) = v1;
            const int rbase = u.pm * 256 + ai * 128 + wr * 64 + m * 16;
            float* dst = p->out + (kind == 1 ? OFF_KP : OFF_VP) + ((long)l * MP + rbase) * 512 + (u.pn * 256 + bj * 128 + wc * 32 - kind * 512);
            const f32x4 w0 = *(const LDS f32x4*)(st + (ln >> 3) * 36 + (ln & 7) * 4);
            const f32x4 w1 = *(const LDS f32x4*)(st + (8 + (ln >> 3)) * 36 + (ln & 7) * 4);
            __builtin_nontemporal_store(w0, (f32x4*)(dst + (long)(ln >> 3) * 512 + (ln & 7) * 4));
            __builtin_nontemporal_store(w1, (f32x4*)(dst + (long)(8 + (ln >> 3)) * 512 + (ln & 7) * 4));
          }
        }
      }
  }
};
struct EpiOut {
  static constexpr bool PERM = true, AFTER_DRAIN = false;
  KP p;
  DI void operator()(f32x4 (&acc)[2][2][4][2], const pg8::Unit& u, int wr, int wc, int fr_, int fq_) const {
    const int ln = launder((int)__lane_id()), fr = ln & 15, fq = ln >> 4;
#pragma unroll
    for (int ai = 0; ai < 2; ++ai)
#pragma unroll
      for (int m = 0; m < 4; ++m) {
        const int row = u.pm * 256 + ai * 128 + wr * 64 + m * 16 + fr;
#pragma unroll
        for (int bj = 0; bj < 2; ++bj) {
          const f32x4 v0 = acc[ai][bj][m][0], v1 = acc[ai][bj][m][1];
          const int col = u.pn * 256 + bj * 128 + wc * 32 + 8 * fq;
          u32x4 o; o[0] = pk2(v0[0], v0[1]); o[1] = pk2(v0[2], v0[3]); o[2] = pk2(v1[0], v1[1]); o[3] = pk2(v1[2], v1[3]);
          *(u32x4*)(p->Mo + (long)row * DM + col) = o;
        }
      }
  }
};

template <int EPI>
DI void gemm_phase(KP p, int l, LDS char* shm) {
  {
    KP q = launder_p(p);
    pg8::StaticOrder S; S.init(MP, (EPI != 1) ? INC : DM, (int)gridDim.x, (int)blockIdx.x);
    pg8::Gemm g; g.A = q->H; g.Bt = (EPI != 1) ? q->WtIn + (long)l * INC * 1024 : q->WtOut + (long)l * 1024 * 1024; g.M = MP; g.N = (EPI != 1) ? INC : DM; g.K = 1024;
    if (EPI != 1) { EpiIn E; E.p = q; E.l = l; E.stg = shm + EPI_OFF; pg8::gemm_phase<EpiIn, pg8::StaticOrder, true, true>((PG8_LAS unsigned char*)shm, g, S, E); }
    else { EpiOut E; E.p = q; pg8::gemm_phase<EpiOut, pg8::StaticOrder, true, true>((PG8_LAS unsigned char*)shm, g, S, E); }
    __syncthreads();
  }
  gemm_tiles<EPI, 2>(launder_p(p), l, shm);
}

constexpr int KROW = 144, STG = 2 * 64 * KROW + 128 * KROW;
DI int permk(int i) { return (i & 0x13) | ((i & 8) >> 1) | ((i & 4) << 1); }

template <bool SAMPLE>
DI void attn_unit(KP p, int l, int b, int h, int qb, LDS char* shm) {
  const int tid = launder(threadIdx.x), wid = tid >> 6, lane = tid & 63, rg = wid & 3, map = wid >> 2, r = lane & 31, hh = lane >> 5;
  const int rowbase = SAMPLE ? MP + b * 64 : b * 2048;
  const int nt = SAMPLE ? 33 : 2 * qb + 2;
  const int my_nt = SAMPLE ? (rg < 2 ? 33 : 0) : (2 * qb + 1 + (rg >> 1));
  const int qrow = rowbase + (SAMPLE ? (rg & 1) * 32 : qb * 128 + rg * 32) + r;
  bf16x8 qf[4];
#pragma unroll
  for (int t4 = 0; t4 < 4; ++t4) qf[t4] = *(const bf16x8*)(p->Z + (long)qrow * INC + h * 128 + map * 64 + 16 * t4 + 8 * hh);

  f32x4 kf32[2][2], vf32[4];
  u32x4 kb[2]; u32x2 vb[4];
  const int kkey0 = tid >> 4, kch = tid & 15;
  const int vkg = tid >> 5, vdg = tid & 31;
  auto issue = [&](int t) {
    if (SAMPLE && t < 32) {
      const float* ck = p->cache_k + (((long)(l * 16 + b) * 2048 + t * 64) * 512 + h * 128 + kch * 8);
#pragma unroll
      for (int i = 0; i < 2; ++i) { const float* s = ck + (long)(kkey0 + 32 * i) * 512; kf32[i][0] = *(const f32x4*)s; kf32[i][1] = *(const f32x4*)(s + 4); }
      const float* cv = p->cache_v + (((long)(l * 16 + b) * 2048 + t * 64 + 4 * vkg) * 512 + h * 128 + 4 * vdg);
#pragma unroll
      for (int kk = 0; kk < 4; ++kk) vf32[kk] = *(const f32x4*)(cv + (long)kk * 512);
    } else {
      const long r0 = rowbase + (SAMPLE ? 0 : t * 64);
#pragma unroll
      for (int i = 0; i < 2; ++i) kb[i] = *(const u32x4*)(p->Z + (r0 + kkey0 + 32 * i) * INC + 512 + h * 128 + kch * 8);
#pragma unroll
      for (int kk = 0; kk < 4; ++kk) vb[kk] = *(const u32x2*)(p->Z + (r0 + 4 * vkg + kk) * INC + 1024 + h * 128 + 4 * vdg);
    }
  };
  auto commit = [&](int t, int buf) {
    LDS char* ks = shm + buf * STG;
    LDS char* vs = ks + 2 * 64 * KROW;
    if (SAMPLE && t < 32) {
#pragma unroll
      for (int i = 0; i < 2; ++i) {
        u32x4 o; o[0] = pk2(kf32[i][0][0], kf32[i][0][1]); o[1] = pk2(kf32[i][0][2], kf32[i][0][3]); o[2] = pk2(kf32[i][1][0], kf32[i][1][1]); o[3] = pk2(kf32[i][1][2], kf32[i][1][3]);
        *(LDS u32x4*)(ks + ((kch >> 3) * 64 + kkey0 + 32 * i) * KROW + (kch & 7) * 16) = o;
      }
#pragma unroll
      for (int dd = 0; dd < 4; ++dd) {
        u32x2 o; o[0] = pk2(vf32[0][dd], vf32[1][dd]); o[1] = pk2(vf32[2][dd], vf32[3][dd]);
        *(LDS u32x2*)(vs + (4 * vdg + dd) * KROW + ((((vkg >> 1) ^ (vdg >> 1)) & 7) << 4) + 8 * (vkg & 1)) = o;
      }
    } else {
#pragma unroll
      for (int i = 0; i < 2; ++i) *(LDS u32x4*)(ks + ((kch >> 3) * 64 + kkey0 + 32 * i) * KROW + (kch & 7) * 16) = kb[i];
      u32x2 o;
      o[0] = (vb[0][0] & 0xffffu) | (vb[1][0] << 16); o[1] = (vb[2][0] & 0xffffu) | (vb[3][0] << 16);
      *(LDS u32x2*)(vs + (4 * vdg + 0) * KROW + ((((vkg >> 1) ^ (vdg >> 1)) & 7) << 4) + 8 * (vkg & 1)) = o;
      o[0] = (vb[0][0] >> 16) | (vb[1][0] & 0xffff0000u); o[1] = (vb[2][0] >> 16) | (vb[3][0] & 0xffff0000u);
      *(LDS u32x2*)(vs + (4 * vdg + 1) * KROW + ((((vkg >> 1) ^ (vdg >> 1)) & 7) << 4) + 8 * (vkg & 1)) = o;
      o[0] = (vb[0][1] & 0xffffu) | (vb[1][1] << 16); o[1] = (vb[2][1] & 0xffffu) | (vb[3][1] << 16);
      *(LDS u32x2*)(vs + (4 * vdg + 2) * KROW + ((((vkg >> 1) ^ (vdg >> 1)) & 7) << 4) + 8 * (vkg & 1)) = o;
      o[0] = (vb[0][1] >> 16) | (vb[1][1] & 0xffff0000u); o[1] = (vb[2][1] >> 16) | (vb[3][1] & 0xffff0000u);
      *(LDS u32x2*)(vs + (4 * vdg + 3) * KROW + ((((vkg >> 1) ^ (vdg >> 1)) & 7) << 4) + 8 * (vkg & 1)) = o;
    }
  };

  f32x16 O[4];
#pragma unroll
  for (int dt = 0; dt < 4; ++dt)
#pragma unroll
    for (int g = 0; g < 16; ++g) O[dt][g] = 0.f;
  float m_run = -1e30f, l_run = 0.f;
  const float cscale = 0.125f * 1.44269504089f;
  const int pr = permk(r);

  issue(0); commit(0, 0);
  __syncthreads();
  for (int t = 0; t < nt; ++t) {
    const int cur = t & 1;
    if (t + 1 < nt) issue(t + 1);
    if (t < my_nt) {
      const LDS char* ks = shm + cur * STG + map * (64 * KROW);
      const LDS char* vs = shm + cur * STG + 2 * 64 * KROW;
      f32x16 X0, X1;
#pragma unroll
      for (int g = 0; g < 16; ++g) { X0[g] = 0.f; X1[g] = 0.f; }
#pragma unroll
      for (int t4 = 0; t4 < 4; ++t4) {
        const bf16x8 k0 = *(const LDS bf16x8*)(ks + pr * KROW + (16 * t4 + 8 * hh) * 2);
        const bf16x8 k1 = *(const LDS bf16x8*)(ks + (32 + pr) * KROW + (16 * t4 + 8 * hh) * 2);
        X0 = __builtin_amdgcn_mfma_f32_32x32x16_bf16(k0, qf[t4], X0, 0, 0, 0);
        X1 = __builtin_amdgcn_mfma_f32_32x32x16_bf16(k1, qf[t4], X1, 0, 0, 0);
      }
      float mx = X0[0];
#pragma unroll
      for (int g = 1; g < 16; ++g) mx = fmaxf(mx, X0[g]);
#pragma unroll
      for (int g = 0; g < 16; ++g) mx = fmaxf(mx, X1[g]);
      mx = fmaxf(mx, __shfl_xor(mx, 32));
      const bool need = (mx - m_run) * cscale > 8.0f;
      float alpha = 1.0f;
      if (__any(need)) {
        const float mnew = fmaxf(m_run, mx);
        alpha = __builtin_amdgcn_exp2f((m_run - mnew) * cscale);
        m_run = mnew;
#pragma unroll
        for (int dt = 0; dt < 4; ++dt)
#pragma unroll
          for (int g = 0; g < 16; ++g) O[dt][g] *= alpha;
      }
      const float mc = m_run * cscale;
      float ls = 0.f;
#pragma unroll
      for (int g = 0; g < 16; ++g) { X0[g] = __builtin_amdgcn_exp2f(X0[g] * cscale - mc); ls += X0[g]; }
#pragma unroll
      for (int g = 0; g < 16; ++g) { X1[g] = __builtin_amdgcn_exp2f(X1[g] * cscale - mc); ls += X1[g]; }
      l_run = l_run * alpha + ls;
      bf16x8 pb[2][2];
#pragma unroll
      for (int s = 0; s < 2; ++s) {
        u32x4 a, c;
#pragma unroll
        for (int j = 0; j < 4; ++j) { a[j] = pk2(X0[8 * s + 2 * j], X0[8 * s + 2 * j + 1]); c[j] = pk2(X1[8 * s + 2 * j], X1[8 * s + 2 * j + 1]); }
        pb[0][s] = __builtin_bit_cast(bf16x8, a); pb[1][s] = __builtin_bit_cast(bf16x8, c);
      }
#pragma unroll
      for (int dt = 0; dt < 4; ++dt)
#pragma unroll
        for (int kh = 0; kh < 2; ++kh)
#pragma unroll
          for (int s = 0; s < 2; ++s) {
            const bf16x8 vf = *(const LDS bf16x8*)(vs + (dt * 32 + r) * KROW + ((((kh * 4 + s * 2 + hh) ^ ((dt & 1) * 4 + (r >> 3))) & 7) << 4));
            O[dt] = __builtin_amdgcn_mfma_f32_32x32x16_bf16(vf, pb[kh][s], O[dt], 0, 0, 0);
          }
    }
    if (t + 1 < nt) commit(t + 1, cur ^ 1);
    __syncthreads();
  }
  const bool active = !SAMPLE || rg < 2;
  u32x2 gav[16]; f32x4 gsv[16];
  if (map == 0) {
#pragma unroll
    for (int i = 0; i < 16; ++i) {
      const int dv0 = (i >> 2) * 32 + 8 * (i & 3) + 4 * hh;
      gsv[i] = *(const f32x4*)(p->g_subln + l * 128 + dv0);
      gav[i] = *(const u32x2*)(p->Z + (long)qrow * INC + 1536 + h * 128 + dv0);
    }
  }
  const float ltot = l_run + __shfl_xor(l_run, 32);
  const float inv_l = active ? 1.0f / ltot : 0.f;
  LDS float* xb = (LDS float*)shm;
  if (map == 1 && active) {
#pragma unroll
    for (int dt = 0; dt < 4; ++dt)
#pragma unroll
      for (int g = 0; g < 16; ++g) xb[(rg * 64 + dt * 16 + g) * 64 + lane] = O[dt][g] * inv_l;
  }
  __syncthreads();
  if (map == 0 && active) {
    const float lam = p->lam[l];
    float ss = 0.f;
#pragma unroll
    for (int dt = 0; dt < 4; ++dt)
#pragma unroll
      for (int g = 0; g < 16; ++g) { const float o = O[dt][g] * inv_l - lam * xb[(rg * 64 + dt * 16 + g) * 64 + lane]; O[dt][g] = o; ss += o * o; }
    ss += __shfl_xor(ss, 32);
    const float rs = rsqrtf(ss * (1.0f / 128.0f) + 1e-5f) * (1.0f - p->lam_init[l]);
#pragma unroll
    for (int dt = 0; dt < 4; ++dt)
#pragma unroll
      for (int g4 = 0; g4 < 4; ++g4) {
        const int dv0 = dt * 32 + 8 * g4 + 4 * hh;
        const f32x4 gs = gsv[dt * 4 + g4];
        const u32x2 ga = gav[dt * 4 + g4];
        const float o0 = O[dt][g4 * 4 + 0] * rs * gs[0] * siluf_(bflo(ga[0]));
        const float o1 = O[dt][g4 * 4 + 1] * rs * gs[1] * siluf_(bfhi(ga[0]));
        const float o2 = O[dt][g4 * 4 + 2] * rs * gs[2] * siluf_(bflo(ga[1]));
        const float o3 = O[dt][g4 * 4 + 3] * rs * gs[3] * siluf_(bfhi(ga[1]));
        u32x2 o; o[0] = pk2(o0, o1); o[1] = pk2(o2, o3);
        *(u32x2*)(p->H + (long)qrow * DM + h * 128 + dv0) = o;
      }
  }
}

constexpr int STG2 = 32768;
DI void attn_prompt_unit(KP p, int l, int b, int h, int qb, LDS char* shm) {
  const int tid = launder(threadIdx.x), wid = __builtin_amdgcn_readfirstlane(tid >> 6), lane = tid & 63, rg = wid & 3, map = wid >> 2, r = lane & 31, hh = lane >> 5;
  const int rowbase = b * 2048;
  const int nt = 2 * qb + 2;
  const int my_nt = 2 * qb + 1 + (rg >> 1);
  const int qrow = rowbase + qb * 128 + rg * 32 + r;
  bf16x8 qf[4];
#pragma unroll
  for (int t4 = 0; t4 < 4; ++t4) qf[t4] = *(const bf16x8*)(p->Z + (long)qrow * INC + h * 128 + map * 64 + 16 * t4 + 8 * hh);
  const bf16_t* src[4];
#pragma unroll
  for (int i = 0; i < 4; ++i) {
    const int c = wid + 8 * i, rr = 8 * (c & 7) + (lane >> 3) + ((i >= 2) ? 64 * ((c - 16) >> 3) : 0);
    const int sc = (lane & 7) ^ ((rr >> 1) & 7);
    if (i < 2) src[i] = p->Kc + ((long)((b * 4 + h) * 2 + (c >> 3)) * 2048 + rr) * 64 + sc * 8;
    else src[i] = p->Vt + ((long)(b * 4 + h) * 32 * 128 + rr) * 64 + sc * 8;
  }
  auto issue = [&](int t, int stg) {
#pragma unroll
    for (int i = 0; i < 4; ++i) {
      const bf16_t* g = (i < 2) ? src[i] + t * 4096 : src[i] + t * 8192;
      __builtin_amdgcn_global_load_lds((const unsigned*)g, (LDS unsigned*)(shm + stg * STG2 + (wid + 8 * i) * 1024), 16, 0, 0);
    }
  };
  f32x16 O[4];
#pragma unroll
  for (int dt = 0; dt < 4; ++dt)
#pragma unroll
    for (int g = 0; g < 16; ++g) O[dt][g] = 0.f;
  float m_run = -1e30f, l_run = 0.f;
  const float cscale = 0.125f * 1.44269504089f;
  const int pr = permk(r);
  const int kx = (pr >> 1) & 7, vx = (r >> 1) & 7;
  issue(0, 0);
  if (nt > 1) issue(1, 1);
  if (nt > 1) asm volatile("s_waitcnt vmcnt(4)" ::: "memory"); else asm volatile("s_waitcnt vmcnt(0)" ::: "memory");
  __builtin_amdgcn_s_barrier();
  int b0 = 0, b1 = 1, b2 = 2;
  for (int t = 0; t < nt; ++t) {
    if (t + 2 < nt) issue(t + 2, b2);
    if (t < my_nt) {
      const LDS char* ks = shm + b0 * STG2 + map * 8192;
      const LDS char* vs = shm + b0 * STG2 + 16384;
      f32x16 X0, X1;
#pragma unroll
      for (int g = 0; g < 16; ++g) { X0[g] = 0.f; X1[g] = 0.f; }
#pragma unroll
      for (int t4 = 0; t4 < 4; ++t4) {
        const bf16x8 k0 = *(const LDS bf16x8*)(ks + pr * 128 + (((2 * t4 + hh) ^ kx) << 4));
        const bf16x8 k1 = *(const LDS bf16x8*)(ks + (32 + pr) * 128 + (((2 * t4 + hh) ^ kx) << 4));
        X0 = __builtin_amdgcn_mfma_f32_32x32x16_bf16(k0, qf[t4], X0, 0, 0, 0);
        X1 = __builtin_amdgcn_mfma_f32_32x32x16_bf16(k1, qf[t4], X1, 0, 0, 0);
      }
      float mx = X0[0];
#pragma unroll
      for (int g = 1; g < 16; ++g) mx = fmaxf(mx, X0[g]);
#pragma unroll
      for (int g = 0; g < 16; ++g) mx = fmaxf(mx, X1[g]);
      mx = xhalf_max(mx);
      const bool need = (mx - m_run) * cscale > 8.0f;
      float alpha = 1.0f;
      if (__any(need)) {
        const float mnew = fmaxf(m_run, mx);
        alpha = __builtin_amdgcn_exp2f((m_run - mnew) * cscale);
        m_run = mnew;
#pragma unroll
        for (int dt = 0; dt < 4; ++dt)
#pragma unroll
          for (int g = 0; g < 16; ++g) O[dt][g] *= alpha;
      }
      const float mc = m_run * cscale;
      float ls = 0.f;
#pragma unroll
      for (int g = 0; g < 16; ++g) { X0[g] = __builtin_amdgcn_exp2f(X0[g] * cscale - mc); ls += X0[g]; }
#pragma unroll
      for (int g = 0; g < 16; ++g) { X1[g] = __builtin_amdgcn_exp2f(X1[g] * cscale - mc); ls += X1[g]; }
      l_run = l_run * alpha + ls;
      bf16x8 pb[2][2];
#pragma unroll
      for (int s = 0; s < 2; ++s) {
        u32x4 a, c;
#pragma unroll
        for (int j = 0; j < 4; ++j) { a[j] = pk2(X0[8 * s + 2 * j], X0[8 * s + 2 * j + 1]); c[j] = pk2(X1[8 * s + 2 * j], X1[8 * s + 2 * j + 1]); }
        pb[0][s] = __builtin_bit_cast(bf16x8, a); pb[1][s] = __builtin_bit_cast(bf16x8, c);
      }
#pragma unroll
      for (int dt = 0; dt < 4; ++dt)
#pragma unroll
        for (int kh = 0; kh < 2; ++kh)
#pragma unroll
          for (int s = 0; s < 2; ++s) {
            const bf16x8 vf = *(const LDS bf16x8*)(vs + (dt * 32 + r) * 128 + (((kh * 4 + s * 2 + hh) ^ vx) << 4));
            O[dt] = __builtin_amdgcn_mfma_f32_32x32x16_bf16(vf, pb[kh][s], O[dt], 0, 0, 0);
          }
    }
    if (t + 2 < nt) asm volatile("s_waitcnt vmcnt(4)" ::: "memory"); else asm volatile("s_waitcnt vmcnt(0)" ::: "memory");
    asm volatile("s_waitcnt lgkmcnt(0)" ::: "memory");
    __builtin_amdgcn_s_barrier();
    { const int tb = b0; b0 = b1; b1 = b2; b2 = tb; }
  }
  u32x4 gav[8]; f32x4 gsv[16];
  if (map == 0) {
#pragma unroll
    for (int i = 0; i < 8; ++i) {
      const int dvb = (i >> 1) * 32 + 8 * (2 * (i & 1) + hh);
      gsv[2 * i] = *(const f32x4*)(p->g_subln + l * 128 + dvb);
      gsv[2 * i + 1] = *(const f32x4*)(p->g_subln + l * 128 + dvb + 4);
      gav[i] = *(const u32x4*)(p->Z + (long)qrow * INC + 1536 + h * 128 + dvb);
    }
  }
  const float ltot = xhalf_sum(l_run);
  const float inv_l = 1.0f / ltot;
  LDS float* xb = (LDS float*)shm;
  if (map == 1) {
#pragma unroll
    for (int dt = 0; dt < 4; ++dt)
#pragma unroll
      for (int g = 0; g < 16; ++g) xb[(rg * 64 + dt * 16 + g) * 64 + lane] = O[dt][g] * inv_l;
  }
  __syncthreads();
  if (map == 0) {
    const float lam = p->lam[l];
    float ss = 0.f;
#pragma unroll
    for (int dt = 0; dt < 4; ++dt)
#pragma unroll
      for (int g = 0; g < 16; ++g) { const float o = O[dt][g] * inv_l - lam * xb[(rg * 64 + dt * 16 + g) * 64 + lane]; O[dt][g] = o; ss += o * o; }
    ss = xhalf_sum(ss);
    const float rs = rsqrtf(ss * (1.0f / 128.0f) + 1e-5f) * (1.0f - p->lam_init[l]);
#pragma unroll
    for (int dt = 0; dt < 4; ++dt)
#pragma unroll
      for (int kp = 0; kp < 2; ++kp) {
        const int i = dt * 2 + kp, dvb = dt * 32 + 8 * (2 * kp + hh);
        f32x4 av, bv;
#pragma unroll
        for (int j = 0; j < 4; ++j) {
          const auto sw = __builtin_amdgcn_permlane32_swap(__float_as_uint(O[dt][8 * kp + j] * rs), __float_as_uint(O[dt][8 * kp + 4 + j] * rs), false, false);
          av[j] = __uint_as_float(sw[0]); bv[j] = __uint_as_float(sw[1]);
        }
        const f32x4 g0 = gsv[2 * i], g1 = gsv[2 * i + 1];
        const u32x4 ga = gav[i];
        u32x4 o;
        o[0] = pk2(av[0] * g0[0] * siluf_(bflo(ga[0])), av[1] * g0[1] * siluf_(bfhi(ga[0])));
        o[1] = pk2(av[2] * g0[2] * siluf_(bflo(ga[1])), av[3] * g0[3] * siluf_(bfhi(ga[1])));
        o[2] = pk2(bv[0] * g1[0] * siluf_(bflo(ga[2])), bv[1] * g1[1] * siluf_(bfhi(ga[2])));
        o[3] = pk2(bv[2] * g1[2] * siluf_(bflo(ga[3])), bv[3] * g1[3] * siluf_(bfhi(ga[3])));
        *(u32x4*)(p->H + (long)qrow * DM + h * 128 + dvb) = o;
      }
  }
}

DI void conv_unit(KP p, int l, int cu, LDS char* shm) {
  const int tid = launder(threadIdx.x), lane = tid & 63, wid = tid >> 6;
  const bool smp = cu >= 1024;
  const int b = smp ? cu - 1024 : cu >> 5, t0 = smp ? 0 : (cu & 31) * 64;
  const int rowbase = smp ? MP + b * 64 : b * 2048, S = smp ? 64 : 2048;
  const int c = tid;
  float w[31], win[32];
#pragma unroll
  for (int j = 0; j < 31; ++j) w[j] = p->w_dw[(l * 31 + j) * 512 + c];
#pragma unroll
  for (int j = 0; j < 32; ++j) win[j] = 0.f;
  const float bias = p->b_dw[l * 512 + c];
  LDS float* ct = (LDS float*)shm;
  float* cso = p->out + (smp ? OFF_CS + (long)(l * 16 + b) * 30 * 512 : OFF_CP + (long)(l * 32 + b) * 30 * 512);
  const bf16_t* zb = p->Z + (long)rowbase * INC + 2048;
#pragma unroll 1
  for (int base = 0; base < 96; base += 32) {
    float un[32];
#pragma unroll
    for (int k = 0; k < 32; ++k) un[k] = 0.f;
    if (smp && base == 0) {
#pragma unroll
      for (int k = 0; k < 30; ++k) un[k] = p->state_conv[((long)(l * 16 + b) * 30 + k) * 512 + c];
    }
    bf16_t ra[32], rb[32];
#pragma unroll
    for (int k = 0; k < 32; ++k) {
      const int tau = t0 - 30 + base + k;
      const int tc = tau < 0 ? 0 : (tau > S - 1 ? S - 1 : tau);
      const bf16_t* zr = zb + (long)tc * INC;
      ra[k] = zr[c]; rb[k] = smp ? zr[512 + c] : (bf16_t)0;
    }
    __builtin_amdgcn_sched_barrier(0);
#pragma unroll
    for (int k = 0; k < 32; ++k) {
      const int tau = t0 - 30 + base + k;
      const float u = smp ? bf1(ra[k]) * sigmoidf_(bf1(rb[k])) : bf1(ra[k]);
      un[k] = (tau >= 0) ? u : un[k];
    }
    if (smp && base == 64 && t0 + 64 == S) {
#pragma unroll
      for (int k = 0; k < 30; ++k) cso[(long)k * 512 + c] = un[k];
    }
#pragma unroll
    for (int k = 0; k < 32; ++k) {
      const int ti = base + k;
      win[k] = un[k];
      float a = bias;
#pragma unroll
      for (int j = 0; j < 31; ++j) a += w[j] * win[(k + 2 + j) & 31];
      if (ti >= 30 && ti < 94) ct[(ti - 30) * 512 + c] = a;
    }
  }
  __syncthreads();
  for (int tt = wid; tt < 64; tt += 8) {
    const long row = rowbase + t0 + tt;
    const f32x4 a0 = *(const LDS f32x4*)(ct + tt * 512 + lane * 8);
    const f32x4 a1 = *(const LDS f32x4*)(ct + tt * 512 + lane * 8 + 4);
    float s = (a0[0] + a0[1]) + (a0[2] + a0[3]) + (a1[0] + a1[1]) + (a1[2] + a1[3]);
    s = wave_sum(s);
    const float mean = s * (1.0f / 512.0f);
    const f32x4 d0 = a0 - mean, d1 = a1 - mean;
    float q = d0[0] * d0[0] + d0[1] * d0[1] + d0[2] * d0[2] + d0[3] * d0[3] + d1[0] * d1[0] + d1[1] * d1[1] + d1[2] * d1[2] + d1[3] * d1[3];
    q = wave_sum(q);
    const float rstd = rsqrtf(q * (1.0f / 512.0f) + 1e-5f);
    const u32x4 gc = *(const u32x4*)(p->Z + row * INC + 3072 + lane * 8);
    const f32x4 g0 = *(const f32x4*)(p->g_ln + l * 512 + lane * 8), g1 = *(const f32x4*)(p->g_ln + l * 512 + lane * 8 + 4);
    const f32x4 b0 = *(const f32x4*)(p->b_ln + l * 512 + lane * 8), b1 = *(const f32x4*)(p->b_ln + l * 512 + lane * 8 + 4);
    const f32x4 y0 = d0 * rstd * g0 + b0, y1 = d1 * rstd * g1 + b1;
    u32x4 o;
    o[0] = pk2(siluf_(y0[0]) * siluf_(bflo(gc[0])), siluf_(y0[1]) * siluf_(bfhi(gc[0])));
    o[1] = pk2(siluf_(y0[2]) * siluf_(bflo(gc[1])), siluf_(y0[3]) * siluf_(bfhi(gc[1])));
    o[2] = pk2(siluf_(y1[0]) * siluf_(bflo(gc[2])), siluf_(y1[1]) * siluf_(bfhi(gc[2])));
    o[3] = pk2(siluf_(y1[2]) * siluf_(bflo(gc[3])), siluf_(y1[3]) * siluf_(bfhi(gc[3])));
    *(u32x4*)(p->H + row * DM + 512 + lane * 8) = o;
  }
}

DI void phase_mix(KP p, int l, LDS char* shm, int ci) {
  const int tid = launder(threadIdx.x);
  if (gridDim.x == 256) {
    const int xcd = blockIdx.x & 7, cq = blockIdx.x >> 3, which = cq >> 4, qi = cq & 15;
#pragma unroll 1
    for (int r = 0; r < 8; ++r) {
      const int bb = 4 * xcd + (r >> 1), hd = 2 * (r & 1) + which;
      const int qb = (r & 1) ? 15 - qi : qi;
      attn_prompt_unit(launder_p(p), l, bb, hd, qb, shm);
      __syncthreads();
    }
  } else {
#pragma unroll 1
    for (int u = blockIdx.x; u < N_ATT_P; u += gridDim.x) {
      attn_prompt_unit(launder_p(p), l, (u & 127) >> 2, u & 3, 15 - (u >> 7), shm);
      __syncthreads();
    }
  }
  for (;;) {
    if (tid == 0) *(LDS volatile int*)(shm + QOFF) = (int)atomicAdd(p->ctr + ci, 1u);
    __syncthreads();
    const int it = *(LDS volatile int*)(shm + QOFF);
    __syncthreads();
    if (it >= N_ATT_S + N_CONV) break;
    p = launder_p(p);
    if (it < N_ATT_S) attn_unit<true>(p, l, it >> 2, it & 3, 0, shm);
    else conv_unit(p, l, it - N_ATT_S, shm);
    __syncthreads();
  }
}

#define XB_TMO      128
#define XB_XCNT(j)  (256  + 64 * (j))
#define XB_XSUB(j)  (1280 + 64 * (j))
#define XB_XGEN(j)  (2304 + 64 * (j))
#define XB_TOP      3328
#define XB_TOPGEN   3392
#define XCD_BAR_WORDS 3456
#define XB_SPIN_CAP (1u << 18)

__device__ __forceinline__ unsigned xb_ld(unsigned* p)              { return __hip_atomic_load(p, __ATOMIC_RELAXED, __HIP_MEMORY_SCOPE_AGENT); }
__device__ __forceinline__ unsigned xb_add(unsigned* p, unsigned v) { return __hip_atomic_fetch_add(p, v, __ATOMIC_RELAXED, __HIP_MEMORY_SCOPE_AGENT); }
__device__ __forceinline__ unsigned xb_xcc_id() { return (unsigned)__builtin_amdgcn_s_getreg((3 << 11) | 20) & 0xFu; }
#define XB_SPIN(cond, bar) do { unsigned _sp = 0; while (cond) { __builtin_amdgcn_s_sleep(1); \
    if ((++_sp & 255u) == 0u) { if (xb_ld(&(bar)[XB_TMO])) break; if (_sp > XB_SPIN_CAP) { atomicAdd(&(bar)[XB_TMO], 1u); break; } } } } while (0)

struct XcdBarrier {
    unsigned* bar; unsigned x;
    volatile LDS unsigned* st;
};

__device__ __forceinline__ XcdBarrier xcd_barrier_post(unsigned* bar, volatile LDS unsigned* st) {
    XcdBarrier b; b.bar = bar; b.x = xb_xcc_id(); b.st = st;
    if (threadIdx.x == 0) (void)xb_add(&bar[XB_XCNT(b.x)], 1u);
    return b;
}
__device__ __forceinline__ void xcd_barrier_complete(unsigned* bar, unsigned x, unsigned& nloc, unsigned& nx) {
    const unsigned G = gridDim.x * gridDim.y * gridDim.z;
    unsigned sum, cnt, mine, sp = 0u;
    for (;;) {
        sum = 0u; cnt = 0u; mine = 0u;
#pragma unroll
        for (unsigned j = 0; j < 16; ++j) { const unsigned c = xb_ld(&bar[XB_XCNT(j)]); sum += c; cnt += (c > 0u) ? 1u : 0u; mine = (j == x) ? c : mine; }
        if (sum == G) break;
        __builtin_amdgcn_s_sleep(1);
        if ((++sp & 255u) == 0u) { if (xb_ld(&bar[XB_TMO])) break; if (sp > XB_SPIN_CAP) { atomicAdd(&bar[XB_TMO], 1u); break; } }
    }
    nloc = mine > 0u ? mine : 1u; nx = cnt > 0u ? cnt : 1u;
}

__device__ __forceinline__ void xcd_barrier(const XcdBarrier& b) {
    asm volatile("s_waitcnt vmcnt(0)" ::: "memory");
    __syncthreads();
    if (threadIdx.x == 0) {
        unsigned* bar = b.bar;
        __builtin_amdgcn_s_waitcnt(0);
        unsigned nloc = b.st[0], nx = b.st[1];
        if (nloc == 0u) { xcd_barrier_complete(bar, b.x, nloc, nx); b.st[0] = nloc; b.st[1] = nx; }
        const unsigned old = xb_add(&bar[XB_XSUB(b.x)], 1u);
        const unsigned gen = old / nloc;
        if (old + 1u == (gen + 1u) * nloc) {
            __builtin_amdgcn_fence(__ATOMIC_RELEASE, "agent");
            asm volatile("s_waitcnt vmcnt(0)" ::: "memory");
            const unsigned og = xb_add(&bar[XB_TOP], 1u);
            const unsigned tg = og / nx;
            if (og + 1u == (tg + 1u) * nx) xb_add(&bar[XB_TOPGEN], 1u);
            else XB_SPIN(xb_ld(&bar[XB_TOPGEN]) == tg, bar);
            __builtin_amdgcn_fence(__ATOMIC_ACQUIRE, "agent");
            xb_add(&bar[XB_XGEN(b.x)], 1u);
            asm volatile("s_waitcnt vmcnt(0)" ::: "memory");
        } else {
            XB_SPIN(xb_ld(&bar[XB_XGEN(b.x)]) == gen, bar);
            __builtin_amdgcn_fence(__ATOMIC_ACQUIRE, "agent");
            asm volatile("s_waitcnt vmcnt(0)" ::: "memory");
        }
    }
    __syncthreads();
}

__global__ void __launch_bounds__(512, 2) mega_fwd(Params pv) {
  __shared__ __attribute__((aligned(1024))) char shm_[SHM_BYTES];
  LDS char* shm = (LDS char*)shm_;
  cg::grid_group grid = cg::this_grid();
  KP p0 = (KP)__builtin_amdgcn_kernarg_segment_ptr();
  if (p0->phase_lo == 777) grid.sync();
  volatile LDS unsigned* xst = (volatile LDS unsigned*)(shm + QOFF + 16);
  if (threadIdx.x == 0) { xst[0] = 0u; xst[1] = 0u; }
  __syncthreads();
  const XcdBarrier xb = xcd_barrier_post(p0->bar, xst);
  phase0(launder_p(p0), shm);              xcd_barrier(xb);
  phase_rows<0>(launder_p(p0));            xcd_barrier(xb);
  gemm_phase<0>(launder_p(p0), 0, shm);    xcd_barrier(xb);
#ifdef PROBE_GEMM
  gemm_phase<0>(launder_p(p0), 0, shm);    xcd_barrier(xb);
#endif
#ifdef PROBE_GEMM_NOEPI
  gemm_phase<2>(launder_p(p0), 0, shm);    xcd_barrier(xb);
#endif
#ifdef PROBE_GEMM_IN
  gemm_phase<0>(launder_p(p0), 0, shm);    xcd_barrier(xb);
#endif
  phase_mix(launder_p(p0), 0, shm, 0);        xcd_barrier(xb);
#ifdef PROBE_MIX
  phase_mix(launder_p(p0), 0, shm, 2);        xcd_barrier(xb);
#endif
  gemm_phase<1>(launder_p(p0), 0, shm);    xcd_barrier(xb);
#ifdef PROBE_GEMM
  gemm_phase<1>(launder_p(p0), 0, shm);    xcd_barrier(xb);
#endif
  phase_rows<1>(launder_p(p0));            xcd_barrier(xb);
  gemm_phase<0>(launder_p(p0), 1, shm);    xcd_barrier(xb);
  phase_mix(launder_p(p0), 1, shm, 1);        xcd_barrier(xb);
  gemm_phase<1>(launder_p(p0), 1, shm);    xcd_barrier(xb);
  phase_rows<2>(launder_p(p0));
}

extern "C" void kernel_launch(void* const* d_in, const int* in_sizes, int n_in, void* d_out, int out_size, void* d_ws, size_t ws_size, hipStream_t stream) {
  Params p{};
  const float* const* in = (const float* const*)d_in;
  p.x_p = in[0]; p.x_s = in[1]; p.c_p = in[2]; p.c_s = in[3]; p.cache_k = in[4]; p.cache_v = in[5]; p.state_conv = in[6];
  p.w_ada = in[7]; p.b_ada = in[8]; p.g_pre = in[9]; p.g_post = in[10]; p.w_in = in[11]; p.w_out = in[12];
  p.lq1 = in[13]; p.lk1 = in[14]; p.lq2 = in[15]; p.lk2 = in[16]; p.g_subln = in[17]; p.w_dw = in[18]; p.b_dw = in[19]; p.g_ln = in[20]; p.b_ln = in[21];
  p.out = (float*)d_out;
  char* ws = (char*)d_ws;
  size_t off = 0;
  auto take = [&](size_t bytes) { char* r = ws + off; off += (bytes + 1023) & ~(size_t)1023; return r; };
  p.ctr = (unsigned*)take(1024);
  p.bar = (unsigned*)take((size_t)XCD_BAR_WORDS * 4);
  p.lam = (float*)take(1024);
  p.rope = (f32x2*)take(2112 * 8 * 8);
  p.mod = (float*)take((size_t)2 * 48 * 3072 * 4);
  p.WtIn = (bf16_t*)take((size_t)2 * INC * 1024 * 2);
  p.WtOut = (bf16_t*)take((size_t)2 * 1024 * 1024 * 2);
  p.WtGluS = (bf16_t*)take((size_t)2 * 1024 * 1024 * 2);
  p.H = (bf16_t*)take((size_t)MT * 1024 * 2);
  p.Mo = (bf16_t*)take((size_t)MT * 1024 * 2);
  p.Z = (bf16_t*)take((size_t)MT * INC * 2);
  p.Vt = (bf16_t*)take((size_t)MP * 512 * 2);
  p.Kc = (bf16_t*)take((size_t)MP * 512 * 2);
  p.X1 = (bf16_t*)take((size_t)MT * 1024 * 2);
  for (int i = 0; i < 8; ++i) p.inv[i] = pow(500000.0, -(double)i / 8.0);
  for (int l = 0; l < 2; ++l) p.lam_init[l] = (float)(0.8 - 0.6 * exp(-0.3 * (double)l));
  p.phase_lo = 0; p.phase_hi = 9;
  static int grid_blocks = 0;
  if (!grid_blocks) {
    int dev = 0, cus = 0, per_cu = 0;
    hipGetDevice(&dev);
    hipDeviceGetAttribute(&cus, hipDeviceAttributeMultiprocessorCount, dev);
    hipOccupancyMaxActiveBlocksPerMultiprocessor(&per_cu, mega_fwd, 512, 0);
    if (per_cu < 1) per_cu = 1;
    grid_blocks = cus * 1;
    if (grid_blocks > 256) grid_blocks = 256;
  }
  hipMemsetAsync(p.bar, 0, (size_t)XCD_BAR_WORDS * 4, stream);
  void* args[] = {&p};
  hipError_t e = hipLaunchCooperativeKernel((void*)mega_fwd, dim3(grid_blocks), dim3(512), args, 0, stream);
  if (e != hipSuccess) fprintf(stderr, "cooperative launch failed: %s (grid %d)\n", hipGetErrorString(e), grid_blocks);
}
```
